# Optimizing an MI355X kernel written in HIP

```python
import jax, jax.numpy as jnp
from jax import lax
import numpy as np

D_MODEL = 4096
BATCH = 2
SEQ = 4096
DEPTH = 1
DEC_BATCH = 8
DEC_SEQ = 32
PAST_LEN = 4096

CHUNK = 64
SB_Q_BLOCK = 128
SB_HEAD_DIM = 128
SB_WIDTH = D_MODEL // 2
SB_HEADS = SB_WIDTH // SB_HEAD_DIM
ML_V_DIM = 512
ML_QK_DIM = ML_V_DIM // 2
ML_V_WIDTH = D_MODEL - SB_WIDTH
ML_HEADS = ML_V_WIDTH // ML_V_DIM
ML_QK_WIDTH = ML_HEADS * ML_QK_DIM
MIX_WIDTH = SB_WIDTH + ML_V_WIDTH
D_FF = 256 * ((8 * D_MODEL // 3 + 255) // 256)
PLE_DIM = 256
EPS = 1e-6
F_BIAS_LO = 3.0
F_BIAS_HI = 6.0
IN_WIDTHS = (SB_WIDTH, SB_WIDTH, SB_WIDTH, ML_QK_WIDTH, ML_QK_WIDTH, ML_V_WIDTH, ML_V_WIDTH, 2 * ML_HEADS)
IN_WIDTH = sum(IN_WIDTHS)
IN_SPLITS = tuple(int(s) for s in np.cumsum(IN_WIDTHS)[:-1])

kernel_name = 'hybrid_stickbreak_mlstm_streaming_step'

F32 = jnp.float32


def rmsnorm(x, g):
    xf = x.astype(F32)
    y = xf * lax.rsqrt(jnp.mean(xf * xf, axis=-1, keepdims=True) + EPS)
    return (y * g.astype(F32)).astype(x.dtype)


def half_ffn(x, ln, w_gate, w_up, w_down):
    h = rmsnorm(x, ln)
    return x + 0.5 * ((jax.nn.silu(h @ w_gate) * (h @ w_up)) @ w_down)


def mixer_heads(h, w_in, b_if):
    B, L, _ = h.shape
    z = h @ w_in
    sb_q, sb_k, sb_v, ml_q, ml_k, ml_v, ml_o, ml_g = jnp.split(z, IN_SPLITS, axis=-1)
    sb_q, sb_k, sb_v = [a.reshape(B, L, SB_HEADS, SB_HEAD_DIM) for a in (sb_q, sb_k, sb_v)]

    def ml_heads(a, d):
        return jnp.transpose(a.reshape(B, L, ML_HEADS, d), (0, 2, 1, 3)).astype(F32)

    ml_q = ml_heads(ml_q, ML_QK_DIM) * (ML_QK_DIM ** -0.5)
    ml_k = ml_heads(ml_k, ML_QK_DIM)
    ml_v = ml_heads(ml_v, ML_V_DIM)
    gates = jnp.transpose((ml_g + b_if).astype(F32), (0, 2, 1))
    i_pre = gates[:, :ML_HEADS]
    log_f = jax.nn.log_sigmoid(gates[:, ML_HEADS:])
    return sb_q, sb_k, sb_v, ml_q, ml_k, ml_v, ml_o, i_pre, log_f


def sb_block(q, k, v, q_pos, k_pos):
    z = jnp.einsum('bqhd,bkhd->bhqk', q, k).astype(F32) * (SB_HEAD_DIM ** -0.5)
    mask = k_pos[None, :] < q_pos[:, None]
    log_1m = jnp.where(mask, -jax.nn.softplus(z), 0.0)
    after = lax.cumsum(log_1m, axis=3, reverse=True) - log_1m
    a = jnp.where(mask, jnp.exp(jax.nn.log_sigmoid(z) + after), 0.0)
    return jnp.einsum('bhqk,bkhd->bqhd', a, v.astype(F32))


def sb_prompt(q, k, v):
    B, S = q.shape[0], q.shape[1]
    nb = S // SB_Q_BLOCK
    pos = jnp.arange(S)
    qb = jnp.moveaxis(q.reshape(B, nb, SB_Q_BLOCK, SB_HEADS, SB_HEAD_DIM), 1, 0)
    pb = pos.reshape(nb, SB_Q_BLOCK)
    out = lax.map(lambda a: sb_block(a[0], k, v, a[1], pos), (qb, pb))
    return jnp.moveaxis(out, 0, 1).reshape(B, S, SB_HEADS, SB_HEAD_DIM)


def sb_step(q, k_new, v_new, k_cache, v_cache):
    P, L = k_cache.shape[1], q.shape[1]
    k = jnp.concatenate([k_cache, k_new.astype(k_cache.dtype)], axis=1)
    v = jnp.concatenate([v_cache, v_new.astype(v_cache.dtype)], axis=1)
    return sb_block(q, k, v, P + jnp.arange(L), jnp.arange(P + L))


def mlstm_chunk(carry, q, k, v, i_pre, log_f):
    C, n, m = carry
    L = q.shape[2]
    b = jnp.cumsum(log_f, axis=-1)
    causal = jnp.tril(jnp.ones((L, L), dtype=bool))
    d_log = jnp.where(causal, b[..., :, None] - b[..., None, :] + i_pre[..., None, :], -jnp.inf)
    inter_log = b + m[..., None]
    m_row = jnp.maximum(inter_log, jnp.max(d_log, axis=-1))
    w_intra = jnp.exp(d_log - m_row[..., None])
    w_inter = jnp.exp(inter_log - m_row)
    s = jnp.einsum('bhtd,bhsd->bhts', q, k) * w_intra
    num = w_inter[..., None] * jnp.einsum('bhvd,bhtd->bhtv', C, q) + jnp.einsum('bhts,bhsv->bhtv', s, v)
    den = w_inter * jnp.einsum('bhd,bhtd->bht', n, q) + jnp.sum(s, axis=-1)
    h = num / jnp.maximum(jnp.abs(den), jnp.exp(-m_row))[..., None]
    m_new = m_row[..., -1]
    w_prev = jnp.exp(b[..., -1] + m - m_new)
    w_tok = jnp.exp(b[..., -1:] - b + i_pre - m_new[..., None])
    C_new = w_prev[..., None, None] * C + jnp.einsum('bhs,bhsv,bhsd->bhvd', w_tok, v, k)
    n_new = w_prev[..., None] * n + jnp.einsum('bhs,bhsd->bhd', w_tok, k)
    return (C_new, n_new, m_new), h


def mlstm_prompt(q, k, v, i_pre, log_f):
    B, H, S = q.shape[0], q.shape[1], q.shape[2]
    nc = S // CHUNK

    def to_chunks(a):
        return jnp.moveaxis(a.reshape(a.shape[:2] + (nc, CHUNK) + a.shape[3:]), 2, 0)

    carry0 = (jnp.zeros((B, H, ML_V_DIM, ML_QK_DIM), F32),
              jnp.zeros((B, H, ML_QK_DIM), F32),
              jnp.zeros((B, H), F32))
    carry, h = lax.scan(lambda c, xs: mlstm_chunk(c, *xs), carry0,
                        (to_chunks(q), to_chunks(k), to_chunks(v), to_chunks(i_pre), to_chunks(log_f)))
    h = jnp.moveaxis(h, 0, 2).reshape(B, H, S, ML_V_DIM)
    return carry, h


def layer_pre(x, ln1, w1g, w1u, w1d, ln_mix, w_in, b_if):
    x = half_ffn(x, ln1, w1g, w1u, w1d)
    return x, mixer_heads(rmsnorm(x, ln_mix), w_in, b_if)


def layer_post(x, sb_h, ml_h, ml_o, p, g_sb, g_ml, w_out, ln2, w2g, w2u, w2d, ln_ple, w_pg, w_pp):
    B, L, _ = x.shape
    sb = rmsnorm(sb_h, g_sb).reshape(B, L, SB_WIDTH)
    ml = rmsnorm(jnp.transpose(ml_h, (0, 2, 1, 3)), g_ml) * jax.nn.sigmoid(
        ml_o.reshape(B, L, ML_HEADS, ML_V_DIM).astype(F32))
    mixed = jnp.concatenate([sb, ml.reshape(B, L, ML_V_WIDTH)], axis=-1).astype(x.dtype)
    x = x + mixed @ w_out
    x = half_ffn(x, ln2, w2g, w2u, w2d)
    gate = jax.nn.sigmoid(rmsnorm(x, ln_ple) @ w_pg)
    return x + gate * (p @ w_pp)


def setup_inputs(seed: int = 0) -> dict:
    key = jax.random.key(seed)
    ks = iter(jax.random.split(key, 40))

    def nrm(shape, scale=1.0):
        return jax.random.normal(next(ks), shape, F32) * scale

    def gain(shape):
        return 1.0 + nrm(shape, 0.02)

    D, F = D_MODEL, D_FF
    b_i = nrm((DEPTH, ML_HEADS), 0.1)
    b_f = jnp.linspace(F_BIAS_LO, F_BIAS_HI, ML_HEADS, dtype=F32)[None, :] + nrm((DEPTH, ML_HEADS), 0.1)
    b_if = jnp.concatenate([b_i, b_f], axis=-1)
    return {
        'x_prompt': nrm((BATCH, SEQ, D)),
        'x_sample': nrm((DEC_BATCH, DEC_SEQ, D)),
        'cache_sb_k': nrm((DEPTH, DEC_BATCH, PAST_LEN, SB_HEADS, SB_HEAD_DIM)),
        'cache_sb_v': nrm((DEPTH, DEC_BATCH, PAST_LEN, SB_HEADS, SB_HEAD_DIM)),
        'state_ml_c': nrm((DEPTH, DEC_BATCH, ML_HEADS, ML_V_DIM, ML_QK_DIM)),
        'state_ml_n': nrm((DEPTH, DEC_BATCH, ML_HEADS, ML_QK_DIM)),
        'state_ml_m': nrm((DEPTH, DEC_BATCH, ML_HEADS)),
        'p_prompt': nrm((DEPTH, BATCH, SEQ, PLE_DIM)),
        'p_sample': nrm((DEPTH, DEC_BATCH, DEC_SEQ, PLE_DIM)),
        'ln_ffn1': gain((DEPTH, D)),
        'w_ffn1_gate': nrm((DEPTH, D, F), D ** -0.5),
        'w_ffn1_up': nrm((DEPTH, D, F), D ** -0.5),
        'w_ffn1_down': nrm((DEPTH, F, D), F ** -0.5),
        'ln_mix': gain((DEPTH, D)),
        'w_in': nrm((DEPTH, D, IN_WIDTH), D ** -0.5),
        'b_if': b_if,
        'g_sb_head': gain((DEPTH, SB_HEADS, SB_HEAD_DIM)),
        'g_ml_head': gain((DEPTH, ML_HEADS, ML_V_DIM)),
        'w_out': nrm((DEPTH, MIX_WIDTH, D), MIX_WIDTH ** -0.5),
        'ln_ffn2': gain((DEPTH, D)),
        'w_ffn2_gate': nrm((DEPTH, D, F), D ** -0.5),
        'w_ffn2_up': nrm((DEPTH, D, F), D ** -0.5),
        'w_ffn2_down': nrm((DEPTH, F, D), F ** -0.5),
        'ln_ple': gain((DEPTH, D)),
        'w_ple_gate': nrm((DEPTH, D, D), D ** -0.5),
        'w_ple_proj': nrm((DEPTH, PLE_DIM, D), PLE_DIM ** -0.5),
        'ln_final': gain((D,)),
    }


def reference(x_prompt, x_sample, cache_sb_k, cache_sb_v, state_ml_c, state_ml_n, state_ml_m,
              p_prompt, p_sample, ln_ffn1, w_ffn1_gate, w_ffn1_up, w_ffn1_down, ln_mix, w_in, b_if,
              g_sb_head, g_ml_head, w_out, ln_ffn2, w_ffn2_gate, w_ffn2_up, w_ffn2_down,
              ln_ple, w_ple_gate, w_ple_proj, ln_final):
    xp, xs = x_prompt, x_sample
    pk, pv, pc, pn, pm = [], [], [], [], []
    sk_l, sv_l, sc, sn, sm = [], [], [], [], []
    for l in range(DEPTH):
        pre_w = (ln_ffn1[l], w_ffn1_gate[l], w_ffn1_up[l], w_ffn1_down[l], ln_mix[l], w_in[l], b_if[l])
        post_w = (g_sb_head[l], g_ml_head[l], w_out[l], ln_ffn2[l], w_ffn2_gate[l], w_ffn2_up[l],
                  w_ffn2_down[l], ln_ple[l], w_ple_gate[l], w_ple_proj[l])
        xp, (sq, sk, sv, mq, mk, mv, mo, mi, mf) = layer_pre(xp, *pre_w)
        sb_h = sb_prompt(sq, sk, sv)
        (c, n, m), ml_h = mlstm_prompt(mq, mk, mv, mi, mf)
        xp = layer_post(xp, sb_h, ml_h, mo, p_prompt[l], *post_w)
        pk.append(sk); pv.append(sv); pc.append(c); pn.append(n); pm.append(m)
        xs, (sq, sk, sv, mq, mk, mv, mo, mi, mf) = layer_pre(xs, *pre_w)
        sb_h = sb_step(sq, sk, sv, cache_sb_k[l], cache_sb_v[l])
        carry = (state_ml_c[l].astype(F32), state_ml_n[l].astype(F32), state_ml_m[l].astype(F32))
        (c, n, m), ml_h = mlstm_chunk(carry, mq, mk, mv, mi, mf)
        xs = layer_post(xs, sb_h, ml_h, mo, p_sample[l], *post_w)
        sk_l.append(sk); sv_l.append(sv); sc.append(c); sn.append(n); sm.append(m)
    y_prompt = rmsnorm(xp, ln_final)
    y_sample = rmsnorm(xs, ln_final)
    return (y_prompt, y_sample,
            jnp.stack(pk), jnp.stack(pv), jnp.stack(pc), jnp.stack(pn), jnp.stack(pm),
            jnp.stack(sk_l), jnp.stack(sv_l), jnp.stack(sc), jnp.stack(sn), jnp.stack(sm))
```

```cpp
#include <hip/hip_runtime.h>
#include <cstdio>
#include <cstdint>

constexpr int NWAVES = 8;
constexpr int D = 4096, MP = 8192, MS = 256, M = MP + MS, FFN = 11008, NGU = 2 * FFN, NIN = 12288, NINF = 12296;
constexpr int SBW = 2048, SBH = 16, SBD = 128, MLH = 4, MLQK = 256, MLV = 512, PLE = 256, SEQ = 4096, PAST = 4096, DSEQ = 32, DBATCH = 8, CHUNK = 64;
constexpr float EPS = 1e-6f;
constexpr int LDX = D, LDH = FFN;
#ifndef MK_N_LAUNCHES
#define MK_N_LAUNCHES 1
#endif
constexpr int N_PHASES = 11;
constexpr size_t OUT_Y = 0, OUT_SBK_P = (size_t)M * D, OUT_SBV_P = OUT_SBK_P + (size_t)MP * SBW, OUT_MLC_P = OUT_SBV_P + (size_t)MP * SBW, OUT_MLN_P = OUT_MLC_P + (size_t)2 * MLH * MLV * MLQK,
    OUT_MLM_P = OUT_MLN_P + 2 * MLH * MLQK, OUT_SBK_S = OUT_MLM_P + 2 * MLH, OUT_SBV_S = OUT_SBK_S + (size_t)MS * SBW, OUT_MLC_S = OUT_SBV_S + (size_t)MS * SBW,
    OUT_MLN_S = OUT_MLC_S + (size_t)DBATCH * MLH * MLV * MLQK, OUT_MLM_S = OUT_MLN_S + DBATCH * MLH * MLQK, OUT_END = OUT_MLM_S + DBATCH * MLH;
static_assert(OUT_END == 74459176, "output size");
constexpr size_t MiB = 1u << 20;
constexpr size_t al(size_t x) { return (x + MiB - 1) / MiB * MiB; }
constexpr size_t WS_CTL = 0, CTL_ZERO_BYTES = 2 * MiB;
constexpr size_t CTL_BAR_BYTE = 16384;
constexpr size_t CTL_SSQ_BYTE = 65536;
constexpr size_t WS_W1GU = 2 * MiB, WS_W1D = WS_W1GU + al((size_t)NGU * LDX * 2), WS_WIN = WS_W1D + al((size_t)D * LDH * 2), WS_WOUT = WS_WIN + al((size_t)NIN * LDX * 2),
    WS_W2GU = WS_WOUT + al((size_t)D * LDX * 2), WS_W2D = WS_W2GU + al((size_t)NGU * LDX * 2), WS_WPG = WS_W2D + al((size_t)D * LDH * 2), WS_WPP = WS_WPG + al((size_t)D * LDX * 2),
    WS_WIF = WS_WPP + al((size_t)D * PLE * 2), WS_XB = WS_WIF + al((size_t)8 * D * 4), WS_HB = WS_XB + al((size_t)M * LDX * 2), WS_QB = WS_HB + al((size_t)M * LDH * 2),
    WS_KB = WS_QB + al((size_t)M * SBW * 2), WS_VB = WS_KB + al((size_t)M * SBW * 2), WS_MQ = WS_VB + al((size_t)M * SBW * 2), WS_MK = WS_MQ + al((size_t)M * 1024 * 2),
    WS_MV = WS_MK + al((size_t)M * 1024 * 2), WS_MO = WS_MV + al((size_t)M * 2048 * 2), WS_GATES = WS_MO + al((size_t)M * 2048 * 2), WS_MIX = WS_GATES + al((size_t)M * 8 * 4),
    WS_PP = WS_MIX + al((size_t)M * LDX * 2), WS_PB = WS_PP + al((size_t)M * D * 2), WS_NUM = WS_PB + al((size_t)M * PLE * 2), WS_DEN = WS_NUM + al((size_t)M * 2048 * 4),
    WS_MLS = WS_DEN + al((size_t)M * 4 * 4), WS_XB8 = WS_MLS + al((size_t)256 * 21504 * 4)  , WS_SLAB = WS_XB8 + al((size_t)M * D)  , WS_END = WS_SLAB + (size_t)256 * 262144;
constexpr size_t CTL_CNT_BYTE = 1 * MiB;
static_assert(CTL_SSQ_BYTE + 6 * (size_t)M * 8 <= CTL_CNT_BYTE && CTL_CNT_BYTE + 8 * 512 * 128 <= CTL_ZERO_BYTES, "ctl");
constexpr int LDS_BYTES = 163840;
constexpr int MISC_OFF = 163840 - 256;

namespace pg8 {
#define PG8_LAS __attribute__((address_space(3)))
typedef unsigned short bf16_t;
typedef short bf16x8 __attribute__((ext_vector_type(8)));
typedef float f32x4 __attribute__((ext_vector_type(4)));
typedef unsigned u32x4 __attribute__((ext_vector_type(4)));
typedef int v8i __attribute__((ext_vector_type(8)));
constexpr int BM = 256, BK = 64, HALF = 128, HTB = HALF * BK * 2  , STAGE_BYTES = 8 * HTB, NXCD = 8, WGM = 8;

__host__ __device__ __forceinline__ int lds_byte(int r, int c) { const int st = (r >> 4) * 2 + (c >> 5), rr = r & 15, cc = c & 31, ob = rr * 64 + cc * 2; return st * 1024 + (ob ^ (((ob >> 9) & 1) << 5)); }
__host__ __device__ __forceinline__ void stage_rc(int b, int& R, int& C) { const int st = b / 1024, sb = b % 1024, swz = sb ^ (((sb >> 9) & 1) << 5); R = (st >> 1) * 16 + swz / 64; C = (st & 1) * 32 + (swz % 64) / 2; }
__host__ __device__ __forceinline__ int perm32(int rho) { const int n = rho >> 4, i = rho & 15; return 8 * (i >> 2) + 4 * n + (i & 3); }

struct Unit { int pm, pn, k0, nk, split, S, s, tile, xw, rx; };
constexpr int SLAB_BYTES = 256 * 256 * 4;
struct Gemm { const bf16_t* A; const bf16_t* Bt; int M, N, K, ld; };

struct StaticOrder {
    int nM, nN, nwg, G, c;
    __host__ __device__ void init(int M, int N, int G_, int c_) { nM = M / BM; nN = N / BM; nwg = nM * nN; G = G_; c = c_; }
    __host__ __device__ bool next(int i, Unit& u) const {
        const long L = (long)i * G + c; if (L >= nwg) return false;
        int wgid = (int)L; { const int q = nwg / NXCD, r = nwg % NXCD, xcd = wgid % NXCD, off = wgid / NXCD; wgid = (xcd < r ? xcd * (q + 1) : r * (q + 1) + (xcd - r) * q) + off; }
        const int nig = WGM * nN, gid = wgid / nig, fm = gid * WGM, gsz = (nM - fm) < WGM ? (nM - fm) : WGM;
        u.pm = fm + ((wgid % nig) % gsz); u.pn = (wgid % nig) / gsz; return true;
    }
    __device__ __forceinline__ void a_ready(const Unit&) const {}
    __device__ __forceinline__ void done(const Unit&) const {}
};
typedef float f32x2_t __attribute__((ext_vector_type(2)));
typedef __bf16 bf16x2_t __attribute__((ext_vector_type(2)));
typedef unsigned u32x2 __attribute__((ext_vector_type(2)));
__device__ __forceinline__ unsigned cvtpk(float lo, float hi) { f32x2_t v = {lo, hi}; bf16x2_t b = __builtin_convertvector(v, bf16x2_t); return __builtin_bit_cast(unsigned, b); }
template <class T> __device__ __forceinline__ T* opq(T* p) { const unsigned long long v = (unsigned long long)p; unsigned lo = __builtin_amdgcn_readfirstlane((unsigned)v), hi = __builtin_amdgcn_readfirstlane((unsigned)(v >> 32));
    asm volatile("" : "+s"(lo), "+s"(hi)); return (T*)(((unsigned long long)hi << 32) | lo); }
__device__ __forceinline__ float opqf(float x) { unsigned v = __builtin_amdgcn_readfirstlane(__float_as_uint(x)); asm volatile("" : "+s"(v)); return __uint_as_float(v); }
constexpr int DM = 4096, DFF = 11008, MPROMPT = 8192;
constexpr float SSQ_SCALE = 16777216.0f;
__device__ __forceinline__ float rs_of(const unsigned long long* ssq, int row) { return rsqrtf((float)ssq[row] * (1.0f / (16777216.0f * 4096.0f)) + 1e-6f); }
__device__ __forceinline__ unsigned pack4_fp8(float a, float b, float c, float d) { int w = __builtin_amdgcn_cvt_pk_fp8_f32(a, b, 0, false); w = __builtin_amdgcn_cvt_pk_fp8_f32(c, d, w, true); return (unsigned)w; }
__device__ __forceinline__ unsigned long long ssq_fix(float s) { return (unsigned long long)(s * SSQ_SCALE + 0.5f); }


struct SplitOrder {
    int nM, nN, nwg, G, c, ntk, Rf, r, split_ok; unsigned char* slab; unsigned* cnt;
    __device__ __forceinline__ void init(int M, int N, int K, int G_, int c_, unsigned char* slab_, unsigned* cnt_) { nM = M / BM; nN = N / BM; nwg = nM * nN; G = __builtin_amdgcn_readfirstlane(G_); c = __builtin_amdgcn_readfirstlane(c_); ntk = K / BK;
        Rf = __builtin_amdgcn_readfirstlane(nwg / G); r = nwg - Rf * G; slab = slab_; cnt = cnt_; split_ok = (G % 8 == 0) && (G >= 64) && (ntk >= 8) && (ntk % 2 == 0); }
    __device__ __forceinline__ void map(int L, Unit& u) const {
        int wgid = L; { const int q = nwg / NXCD, r8 = nwg % NXCD, xcd = wgid % NXCD, off = wgid / NXCD; wgid = (xcd < r8 ? xcd * (q + 1) : r8 * (q + 1) + (xcd - r8) * q) + off; }
        const int nig = WGM * nN, gid = wgid / nig, fm = gid * WGM, gsz = (nM - fm) < WGM ? (nM - fm) : WGM;
        u.pm = __builtin_amdgcn_readfirstlane(fm + ((wgid % nig) % gsz)); u.pn = __builtin_amdgcn_readfirstlane((wgid % nig) / gsz); }
    __device__ __forceinline__ bool next(int i, Unit& u) const {
        u.k0 = 0; u.nk = ntk; u.split = 0; u.S = 1; u.s = 0; u.tile = 0; u.xw = 0; u.rx = 1;
        if (i < Rf) { map(i * G + c, u); return true; }
        if (i > Rf || r == 0) return false;
        if (!split_ok) { if (c >= r) return false; map(Rf * G + c, u); return true; }
        const int x = c & 7, w = c >> 3, W = G >> 3, rx = (x < r) ? (r - x + 7) / 8 : 0;
        if (rx == 0) return false;
        const int s = __builtin_amdgcn_readfirstlane(w / rx), tp = w - s * rx; int S = __builtin_amdgcn_readfirstlane((W - tp + rx - 1) / rx); const int np = ntk / 2; if (S > np / 2) S = np / 2;
        if (s >= S) return false;
        const int j = x + 8 * tp; map(Rf * G + j, u);
        const int p0 = __builtin_amdgcn_readfirstlane((s * np) / S), p1 = __builtin_amdgcn_readfirstlane(((s + 1) * np) / S);
        u.k0 = 2 * p0; u.nk = 2 * (p1 - p0); u.split = (S > 1) ? 1 : 0; u.S = S; u.s = s; u.tile = j; u.xw = x + 8 * tp; u.rx = rx; return true; }
    __device__ __forceinline__ void a_ready(const Unit&) const {}
    __device__ __forceinline__ void done(const Unit&) const {}
};

template <bool W8, bool H8> struct EpiGateUp {
    static constexpr bool PERM = false, AFTER_DRAIN = false;
    unsigned char* ws; size_t h_off; int ssq_k;
    __device__ __forceinline__ void operator()(const f32x4 (&acc)[2][2][4][2], const Unit& u, int wr, int wc, int fr, int fq, unsigned mask) const {
        const int row0 = u.pm * BM + wr * 64 + fr, col0 = u.pn * 128 + wc * 16 + 4 * fq; unsigned char* const wsp = opq(this->ws); bf16_t* const H = (bf16_t*)(wsp + h_off); const unsigned long long* const ssq = (const unsigned long long*)(wsp + CTL_SSQ_BYTE) + (size_t)ssq_k * 8448;
#pragma unroll
        for (int ai = 0; ai < 2; ++ai)
#pragma unroll
            for (int m = 0; m < 4; ++m) { if (!((mask >> ((ai * 4 + m) * 2)) & 3u)) continue; const int row = row0 + ai * HALF + m * 16; const float rs = rs_of(ssq, row) * (W8 ? 0.015625f : 1.0f); bf16_t* rowp = H + (size_t)row * LDH + col0;
#pragma unroll
                for (int bj = 0; bj < 2; ++bj) { if (!((mask >> ((ai * 4 + m) * 2 + bj)) & 1u)) continue; const f32x4 g = acc[ai][bj][m][0] * rs, up = acc[ai][bj][m][1] * rs; f32x4 h;
#pragma unroll
                    for (int e = 0; e < 4; ++e) h[e] = g[e] * __builtin_amdgcn_rcpf(1.0f + __expf(-g[e])) * up[e];
                    if constexpr (H8) *(unsigned*)((unsigned char*)H + (size_t)row * DFF + col0 + bj * 64) = pack4_fp8(h[0], h[1], h[2], h[3]);
                    else { u32x2 w; w.x = cvtpk(h[0], h[1]); w.y = cvtpk(h[2], h[3]); *(u32x2*)(rowp + bj * 64) = w; } } }
    }
};
template <bool OUT8, bool RESB> struct EpiResid {
    static constexpr bool PERM = true, AFTER_DRAIN = false;
    const float* res_p; const float* res_s; unsigned char* ws; float alpha; int ssq_k;
    __device__ __forceinline__ void operator()(const f32x4 (&acc)[2][2][4][2], const Unit& u, int wr, int wc, int fr, int fq, unsigned mask) const {
        const int row0 = u.pm * BM + wr * 64 + fr, col0 = u.pn * BM + wc * 32 + 8 * fq;
        const float* src = RESB ? nullptr : opq((u.pm < 32) ? res_p : (res_s - (size_t)MPROMPT * DM)); unsigned char* const wsp = opq(this->ws); bf16_t* const XB = (bf16_t*)(wsp + WS_XB); unsigned long long* const ssq_out = (unsigned long long*)(wsp + CTL_SSQ_BYTE) + (size_t)ssq_k * 8448; const float alpha = opqf(this->alpha);
#pragma unroll
        for (int ai = 0; ai < 2; ++ai)
#pragma unroll
            for (int m = 0; m < 4; ++m) { if (!((mask >> ((ai * 4 + m) * 2)) & 3u)) continue; const int row = row0 + ai * HALF + m * 16; const size_t off = (size_t)row * DM + col0; float ss = 0.f;
#pragma unroll
                for (int bj = 0; bj < 2; ++bj) { if (!((mask >> ((ai * 4 + m) * 2 + bj)) & 1u)) continue; bf16_t* const xb = XB + (size_t)row * LDX + col0 + bj * HALF; f32x4 r0, r1;
                    if constexpr (RESB) { const u32x4 rw = *(const u32x4*)xb; r0[0] = __uint_as_float(rw.x << 16); r0[1] = __uint_as_float(rw.x & 0xffff0000u); r0[2] = __uint_as_float(rw.y << 16); r0[3] = __uint_as_float(rw.y & 0xffff0000u);
                        r1[0] = __uint_as_float(rw.z << 16); r1[1] = __uint_as_float(rw.z & 0xffff0000u); r1[2] = __uint_as_float(rw.w << 16); r1[3] = __uint_as_float(rw.w & 0xffff0000u); }
                    else { r0 = *(const f32x4*)(src + off + bj * HALF); r1 = *(const f32x4*)(src + off + bj * HALF + 4); }
                    const f32x4 o0 = r0 + acc[ai][bj][m][0] * alpha, o1 = r1 + acc[ai][bj][m][1] * alpha;
                    { u32x4 w; w.x = cvtpk(o0[0], o0[1]); w.y = cvtpk(o0[2], o0[3]); w.z = cvtpk(o1[0], o1[1]); w.w = cvtpk(o1[2], o1[3]); *(u32x4*)xb = w; }
                    if constexpr (OUT8) { u32x2 q; q.x = pack4_fp8(o0[0], o0[1], o0[2], o0[3]); q.y = pack4_fp8(o1[0], o1[1], o1[2], o1[3]); *(u32x2*)(wsp + WS_XB8 + (size_t)row * DM + col0 + bj * HALF) = q; }
                    ss += ((o0[0] * o0[0] + o0[1] * o0[1]) + (o0[2] * o0[2] + o0[3] * o0[3])) + ((o1[0] * o1[0] + o1[1] * o1[1]) + (o1[2] * o1[2] + o1[3] * o1[3])); }
                ss += __shfl_xor(ss, 16); ss += __shfl_xor(ss, 32);
                if (fq == 0) atomicAdd(ssq_out + row, ssq_fix(ss));
                if (m == 3) asm volatile("" ::: "memory"); }
    }
};
struct EpiPle {
    static constexpr bool PERM = true, AFTER_DRAIN = false;
    unsigned char* ws; float zscale;
    __device__ __forceinline__ void operator()(const f32x4 (&acc)[2][2][4][2], const Unit& u, int wr, int wc, int fr, int fq, unsigned mask) const {
        const int row0 = u.pm * BM + wr * 64 + fr, col0 = u.pn * BM + wc * 32 + 8 * fq;
        unsigned char* const wsp = opq(this->ws); const float zscale = opqf(this->zscale); const bf16_t* const PP = (const bf16_t*)(wsp + WS_PP); bf16_t* const XB = (bf16_t*)(wsp + WS_XB); const unsigned long long* const ssq = (const unsigned long long*)(wsp + CTL_SSQ_BYTE) + (size_t)3 * 8448; unsigned long long* const ssq_out = (unsigned long long*)(wsp + CTL_SSQ_BYTE) + (size_t)4 * 8448;
#pragma unroll
        for (int ai = 0; ai < 2; ++ai)
#pragma unroll
            for (int m = 0; m < 4; ++m) { if (!((mask >> ((ai * 4 + m) * 2)) & 3u)) continue; const int row = row0 + ai * HALF + m * 16; const size_t off = (size_t)row * DM + col0; const float rs = rs_of(ssq, row) * zscale; float ss = 0.f;
#pragma unroll
                for (int bj = 0; bj < 2; ++bj) { if (!((mask >> ((ai * 4 + m) * 2 + bj)) & 1u)) continue; bf16_t* const xb = XB + (size_t)row * LDX + col0 + bj * HALF;
                    const u32x4 xw = *(const u32x4*)xb; const u32x4 pw = *(const u32x4*)(PP + off + bj * HALF);
                    const unsigned xs[4] = {xw.x, xw.y, xw.z, xw.w}, ps[4] = {pw.x, pw.y, pw.z, pw.w}; unsigned ow[4];
#pragma unroll
                    for (int n = 0; n < 2; ++n) { const f32x4 z = acc[ai][bj][m][n] * rs;
#pragma unroll
                        for (int hh = 0; hh < 2; ++hh) { const unsigned xv = xs[2 * n + hh], pv = ps[2 * n + hh];
                            const float oa = __uint_as_float(xv << 16) + __builtin_amdgcn_rcpf(1.0f + __expf(-z[2 * hh])) * __uint_as_float(pv << 16);
                            const float ob = __uint_as_float(xv & 0xffff0000u) + __builtin_amdgcn_rcpf(1.0f + __expf(-z[2 * hh + 1])) * __uint_as_float(pv & 0xffff0000u);
                            ow[2 * n + hh] = cvtpk(oa, ob); ss += oa * oa + ob * ob; } }
                    { u32x4 w; w.x = ow[0]; w.y = ow[1]; w.z = ow[2]; w.w = ow[3]; *(u32x4*)xb = w; } }
                ss += __shfl_xor(ss, 16); ss += __shfl_xor(ss, 32);
                if (fq == 0) atomicAdd(ssq_out + row, ssq_fix(ss));
                if (m == 3) asm volatile("" ::: "memory"); }
    }
};
struct EpiPlain {
    static constexpr bool PERM = false, AFTER_DRAIN = false;
    bf16_t* O; int ldc;
    __device__ __forceinline__ void operator()(const f32x4 (&acc)[2][2][4][2], const Unit& u, int wr, int wc, int fr, int fq, unsigned mask) const {
        const int row0 = u.pm * BM + wr * 64 + fr, col0 = u.pn * BM + wc * 32 + 4 * fq;
#pragma unroll
        for (int ai = 0; ai < 2; ++ai)
#pragma unroll
            for (int m = 0; m < 4; ++m) { if (!((mask >> ((ai * 4 + m) * 2)) & 3u)) continue; bf16_t* rowp = opq(O) + (size_t)(row0 + ai * HALF + m * 16) * ldc + col0;
#pragma unroll
                for (int bj = 0; bj < 2; ++bj)
#pragma unroll
                    for (int n = 0; n < 2; ++n) { if (!((mask >> ((ai * 4 + m) * 2 + bj)) & 1u)) continue; const f32x4 v = acc[ai][bj][m][n]; u32x2 w; w.x = cvtpk(v[0], v[1]); w.y = cvtpk(v[2], v[3]); *(u32x2*)(rowp + bj * HALF + n * 16) = w; } }
    }
};
struct EpiWin {
    static constexpr bool PERM = true, AFTER_DRAIN = false;
    unsigned char* ws; float* out;
    __device__ __forceinline__ void operator()(const f32x4 (&acc)[2][2][4][2], const Unit& u, int wr, int wc, int fr, int fq, unsigned mask) const {
        const int row0 = u.pm * BM + wr * 64 + fr; const int pn = u.pn;
        bf16_t* dst; int ld, cbase; float sc = 1.f; float* fdst = nullptr;
        unsigned char* const wsp = opq(this->ws); float* const outp = opq(this->out); size_t doff;
        if (pn < 8) { doff = WS_QB; ld = 2048; cbase = pn * 256; sc = 0.08838834764831845f; }
        else if (pn < 16) { doff = WS_KB; ld = 2048; cbase = (pn - 8) * 256; fdst = (u.pm < 32) ? outp + OUT_SBK_P : (outp + OUT_SBK_S - (size_t)MPROMPT * 2048); }
        else if (pn < 24) { doff = WS_VB; ld = 2048; cbase = (pn - 16) * 256; fdst = (u.pm < 32) ? outp + OUT_SBV_P : (outp + OUT_SBV_S - (size_t)MPROMPT * 2048); }
        else if (pn < 28) { doff = WS_MQ; ld = 1024; cbase = (pn - 24) * 256; sc = 0.0625f; }
        else if (pn < 32) { doff = WS_MK; ld = 1024; cbase = (pn - 28) * 256; }
        else if (pn < 40) { doff = WS_MV; ld = 2048; cbase = (pn - 32) * 256; }
        else { doff = WS_MO; ld = 2048; cbase = (pn - 40) * 256; }
        dst = (bf16_t*)(wsp + doff);
        const int col0 = cbase + wc * 32 + 8 * fq; const unsigned long long* const ssq = (const unsigned long long*)(wsp + CTL_SSQ_BYTE) + (size_t)1 * 8448;
#pragma unroll
        for (int ai = 0; ai < 2; ++ai)
#pragma unroll
            for (int m = 0; m < 4; ++m) { if (!((mask >> ((ai * 4 + m) * 2)) & 3u)) continue; const int row = row0 + ai * HALF + m * 16; const float rs = rs_of(ssq, row) * sc; bf16_t* rowp = dst + (size_t)row * ld + col0;
#pragma unroll
                for (int bj = 0; bj < 2; ++bj) { if (!((mask >> ((ai * 4 + m) * 2 + bj)) & 1u)) continue; const f32x4 v0 = acc[ai][bj][m][0] * rs, v1 = acc[ai][bj][m][1] * rs;
                    u32x4 w; w.x = cvtpk(v0[0], v0[1]); w.y = cvtpk(v0[2], v0[3]); w.z = cvtpk(v1[0], v1[1]); w.w = cvtpk(v1[2], v1[3]);
                    *(u32x4*)(rowp + bj * HALF) = w;
                    if (fdst) { float* fp = fdst + (size_t)row * 2048 + col0 + bj * HALF; *(f32x4*)fp = v0; *(f32x4*)(fp + 4) = v1; } } }
    }
};

template <class Epi, class Sched, bool ALIGN_EPI = false, bool SP2 = false, bool F8 = false>
__device__ __forceinline__ void gemm_phase(PG8_LAS unsigned char* lds, const Gemm g, const Sched& S, const Epi& E) {
    const int tid = threadIdx.x, wid = __builtin_amdgcn_readfirstlane(tid >> 6), lane = tid & 63, wr = wid >> 2, wc = wid & 3, fr = lane & 15, fq = lane >> 4;
    const int K = g.K;
    unsigned voffA[2], voffB[2];
#pragma unroll
    for (int i = 0; i < 2; ++i) { int R, C; stage_rc(tid * 16 + i * 8192, R, C); const int Rb = Epi::PERM ? ((R & ~31) + perm32(R & 31)) : R;
        voffA[i] = (unsigned)(R * g.ld + C) * 2u; voffB[i] = (unsigned)(Rb * g.ld + C) * 2u; }
    const size_t kstep = (size_t)(BK * 2);
    const size_t hstep = (size_t)HALF * g.ld * 2;
    const size_t tstep = 2 * hstep;
    const unsigned ldsw = (unsigned)wid * 1024u;
    const int aoff = lds_byte(wr * 64 + fr, fq * 8), boff = lds_byte(wc * 32 + fr, fq * 8);
    const int aoff8a = lds_byte(wr * 64 + fr, fq * 16), aoff8b = lds_byte(wr * 64 + fr, fq * 16 + 8), boff8a = lds_byte(wc * 32 + fr, fq * 16), boff8b = lds_byte(wc * 32 + fr, fq * 16 + 8);
#define PG8_SA(b, h) (((b) * 2 + (h)) * HTB)
#define PG8_SB(b, h) ((4 + (b) * 2 + (h)) * HTB)
#define PG8_STAGE(bufoff, gbase, voff) do { _Pragma("unroll") for (int _i = 0; _i < 2; ++_i) \
        __builtin_amdgcn_global_load_lds((const unsigned*)((const char*)(gbase) + (voff)[_i]), (PG8_LAS unsigned*)(lds + (bufoff) + ldsw + _i * 8192), 16, 0, 0); } while (0)
#define PG8_LDA(dst, b, h) do { if constexpr (F8) { _Pragma("unroll") for (int m = 0; m < 4; ++m) { const u32x4 lo_ = *(const PG8_LAS u32x4*)(lds + PG8_SA(b, h) + aoff8a + m * 2048), hi_ = *(const PG8_LAS u32x4*)(lds + PG8_SA(b, h) + aoff8b + m * 2048); \
            dst##8[m] = (v8i){(int)lo_.x, (int)lo_.y, (int)lo_.z, (int)lo_.w, (int)hi_.x, (int)hi_.y, (int)hi_.z, (int)hi_.w}; } } \
        else { _Pragma("unroll") for (int m = 0; m < 4; ++m) _Pragma("unroll") for (int k = 0; k < 2; ++k) dst[m][k] = *(const PG8_LAS bf16x8*)(lds + PG8_SA(b, h) + aoff + m * 2048 + k * 1024); } } while (0)
#define PG8_LDB(dst, b, h) do { if constexpr (F8) { _Pragma("unroll") for (int n = 0; n < 2; ++n) { const u32x4 lo_ = *(const PG8_LAS u32x4*)(lds + PG8_SB(b, h) + boff8a + n * 2048), hi_ = *(const PG8_LAS u32x4*)(lds + PG8_SB(b, h) + boff8b + n * 2048); \
            dst##8[n] = (v8i){(int)lo_.x, (int)lo_.y, (int)lo_.z, (int)lo_.w, (int)hi_.x, (int)hi_.y, (int)hi_.z, (int)hi_.w}; } } \
        else { _Pragma("unroll") for (int n = 0; n < 2; ++n) _Pragma("unroll") for (int k = 0; k < 2; ++k) dst[n][k] = *(const PG8_LAS bf16x8*)(lds + PG8_SB(b, h) + boff + n * 2048 + k * 1024); } } while (0)
#define PG8_MMA(ai, bj, At, Bt) do { __builtin_amdgcn_s_setprio(1); \
        if constexpr (F8) { _Pragma("unroll") for (int m = 0; m < 4; ++m) _Pragma("unroll") for (int n = 0; n < 2; ++n) \
            asm volatile("v_mfma_f32_16x16x128_f8f6f4 %0, %1, %2, %0" : "+v"(acc[ai][bj][m][n]) : "v"(Bt##8[n]), "v"(At##8[m])); } \
        else { _Pragma("unroll") for (int m = 0; m < 4; ++m) _Pragma("unroll") for (int n = 0; n < 2; ++n) _Pragma("unroll") for (int k = 0; k < 2; ++k) \
            acc[ai][bj][m][n] = __builtin_amdgcn_mfma_f32_16x16x32_bf16(Bt[n][k], At[m][k], acc[ai][bj][m][n], 0, 0, 0); } __builtin_amdgcn_s_setprio(0); } while (0)
#define PG8_WAIT_V(n) asm volatile("s_waitcnt vmcnt(" #n ")" ::: "memory")
#define PG8_WAIT_L(n) asm volatile("s_waitcnt lgkmcnt(" #n ")" ::: "memory")
#define PG8_BAR __builtin_amdgcn_s_barrier()
#define PG8_SCHED __builtin_amdgcn_sched_barrier(0)
    Unit cur, nxt; int ui = 0;
    if (!S.next(0, cur)) return;
    f32x4 acc[2][2][4][2];
#pragma unroll
    for (int a = 0; a < 2; ++a)
#pragma unroll
        for (int b = 0; b < 2; ++b)
#pragma unroll
            for (int m = 0; m < 4; ++m)
#pragma unroll
                for (int n = 0; n < 2; ++n) acc[a][b][m][n] = (f32x4){0.f, 0.f, 0.f, 0.f};
    bf16x8 At[4][2], B0[2][2], B1[2][2]; v8i At8[4], B08[2], B18[2];
    int sc127 = 127; asm volatile("" : "+v"(sc127));
    const char* cA = (const char*)g.A + (size_t)cur.pm * tstep + (size_t)cur.k0 * kstep; const char* cB = (const char*)g.Bt + (size_t)cur.pn * tstep + (size_t)cur.k0 * kstep;
    S.a_ready(cur);
    if constexpr (SP2) {
        PG8_STAGE(PG8_SB(0, 0), cB, voffB); PG8_STAGE(PG8_SB(0, 1), cB + hstep, voffB); PG8_STAGE(PG8_SA(0, 0), cA, voffA); PG8_STAGE(PG8_SA(0, 1), cA + hstep, voffA);
        if (wr == 1) PG8_BAR;
        PG8_WAIT_V(2); PG8_BAR;
        PG8_STAGE(PG8_SB(1, 0), cB + kstep, voffB); PG8_STAGE(PG8_SA(1, 0), cA + kstep, voffA); PG8_STAGE(PG8_SB(1, 1), cB + hstep + kstep, voffB);
        PG8_WAIT_V(6); PG8_BAR;
    } else {
        PG8_STAGE(PG8_SB(0, 0), cB, voffB); PG8_STAGE(PG8_SA(0, 0), cA, voffA); PG8_STAGE(PG8_SB(0, 1), cB + hstep, voffB); PG8_STAGE(PG8_SA(0, 1), cA + hstep, voffA);
        if (wr == 1) PG8_BAR;
        PG8_WAIT_V(4); PG8_BAR;
        PG8_STAGE(PG8_SB(1, 0), cB + kstep, voffB); PG8_STAGE(PG8_SA(1, 0), cA + kstep, voffA); PG8_STAGE(PG8_SB(1, 1), cB + hstep + kstep, voffB);
        PG8_WAIT_V(6); PG8_BAR;
    }
    for (;;) {
        const bool has_next = S.next(ui + 1, nxt);
        const char* nA = has_next ? (const char*)g.A + (size_t)nxt.pm * tstep + (size_t)nxt.k0 * kstep : cA; const char* nB = has_next ? (const char*)g.Bt + (size_t)nxt.pn * tstep + (size_t)nxt.k0 * kstep : cB;
        const int nt = cur.nk;
        for (int t = 0; t < nt; t += 2) {
            const bool last = (t == nt - 2);
            const char* a1 = cA + (size_t)(t + 1) * kstep;
            const char* a2 = last ? nA : cA + (size_t)(t + 2) * kstep; const char* b2 = last ? nB : cB + (size_t)(t + 2) * kstep;
            const char* a3 = a2 + kstep; const char* b3 = b2 + kstep;
            if (last && has_next) S.a_ready(nxt);
            if constexpr (SP2) {
            PG8_LDB(B0, 0, 0); PG8_LDB(B1, 0, 1); PG8_SCHED; PG8_LDA(At, 0, 0); PG8_STAGE(PG8_SA(1, 1), a1 + hstep, voffA);
            PG8_WAIT_V(8); PG8_WAIT_L(0); PG8_BAR; PG8_MMA(0, 0, At, B0); PG8_MMA(0, 1, At, B1); PG8_BAR; PG8_SCHED;
            PG8_LDA(At, 0, 1); PG8_STAGE(PG8_SB(0, 0), b2, voffB); PG8_STAGE(PG8_SB(0, 1), b2 + hstep, voffB); PG8_STAGE(PG8_SA(0, 0), a2, voffA);
            PG8_WAIT_V(8); PG8_WAIT_L(0); PG8_BAR; PG8_MMA(1, 0, At, B0); PG8_MMA(1, 1, At, B1); PG8_BAR; PG8_SCHED;
            PG8_LDB(B0, 1, 0); PG8_LDB(B1, 1, 1); PG8_SCHED; PG8_LDA(At, 1, 0); PG8_STAGE(PG8_SA(0, 1), a2 + hstep, voffA);
            PG8_WAIT_V(8); PG8_WAIT_L(0); PG8_BAR; PG8_MMA(0, 0, At, B0); PG8_MMA(0, 1, At, B1); PG8_BAR; PG8_SCHED;
            PG8_LDA(At, 1, 1); PG8_STAGE(PG8_SB(1, 0), b3, voffB); PG8_STAGE(PG8_SB(1, 1), b3 + hstep, voffB); PG8_STAGE(PG8_SA(1, 0), a3, voffA);
            PG8_WAIT_V(8); PG8_WAIT_L(0); PG8_BAR; PG8_MMA(1, 0, At, B0); PG8_MMA(1, 1, At, B1); PG8_BAR; PG8_SCHED;
            } else {
            PG8_LDB(B0, 0, 0); PG8_SCHED; PG8_LDA(At, 0, 0); PG8_STAGE(PG8_SA(1, 1), a1 + hstep, voffA);
            PG8_WAIT_L(8); PG8_BAR; PG8_WAIT_L(0); PG8_MMA(0, 0, At, B0); PG8_BAR; PG8_SCHED;
            PG8_LDB(B1, 0, 1); PG8_STAGE(PG8_SB(0, 0), b2, voffB);
            PG8_BAR; PG8_WAIT_L(0); PG8_MMA(0, 1, At, B1); PG8_BAR;
            PG8_LDA(At, 0, 1); PG8_STAGE(PG8_SA(0, 0), a2, voffA);
            PG8_BAR; PG8_WAIT_L(0); PG8_MMA(1, 0, At, B0); PG8_BAR; PG8_SCHED;
            PG8_STAGE(PG8_SB(0, 1), b2 + hstep, voffB);
            PG8_WAIT_V(6); PG8_BAR; PG8_MMA(1, 1, At, B1); PG8_BAR;
            PG8_LDB(B0, 1, 0); PG8_SCHED; PG8_LDA(At, 1, 0); PG8_STAGE(PG8_SA(0, 1), a2 + hstep, voffA);
            PG8_WAIT_L(8); PG8_BAR; PG8_WAIT_L(0); PG8_MMA(0, 0, At, B0); PG8_BAR; PG8_SCHED;
            PG8_LDB(B1, 1, 1); PG8_STAGE(PG8_SB(1, 0), b3, voffB);
            PG8_BAR; PG8_WAIT_L(0); PG8_MMA(0, 1, At, B1); PG8_BAR;
            PG8_LDA(At, 1, 1); PG8_STAGE(PG8_SA(1, 0), a3, voffA);
            PG8_BAR; PG8_WAIT_L(0); PG8_MMA(1, 0, At, B0); PG8_BAR; PG8_SCHED;
            PG8_STAGE(PG8_SB(1, 1), b3 + hstep, voffB);
            PG8_WAIT_V(6); PG8_BAR; PG8_MMA(1, 1, At, B1); PG8_BAR;
            }
        }
        if constexpr (ALIGN_EPI) { if (wr == 0) PG8_BAR; }
        if constexpr (F8) asm volatile("s_nop 15\n\ts_nop 15" ::: "memory");
        if (!cur.split) { E(acc, cur, wr, wc, fr, fq, 0xffffu); }
        if (!has_next) break;
#pragma unroll
        for (int a = 0; a < 2; ++a)
#pragma unroll
            for (int b = 0; b < 2; ++b)
#pragma unroll
                for (int m = 0; m < 4; ++m)
#pragma unroll
                    for (int n = 0; n < 2; ++n) acc[a][b][m][n] = (f32x4){0.f, 0.f, 0.f, 0.f};
        cur = nxt; cA = nA; cB = nB; ++ui;
        if constexpr (ALIGN_EPI) { if (wr == 1) PG8_BAR; }
    }
    PG8_WAIT_V(0);
    if constexpr (!ALIGN_EPI) { if (wr == 0) PG8_BAR; }
    PG8_BAR;
    if (cur.split) {
        const __amdgpu_buffer_rsrc_t rs = __builtin_amdgcn_make_buffer_rsrc((void*)(S.slab + (size_t)S.c * SLAB_BYTES), (short)0, (int)SLAB_BYTES, 0x00020000);
#pragma unroll
        for (int ai = 0; ai < 2; ++ai)
#pragma unroll
            for (int m = 0; m < 4; ++m)
#pragma unroll
                for (int bj = 0; bj < 2; ++bj) { const f32x4 a0 = acc[ai][bj][m][0], a1 = acc[ai][bj][m][1]; u32x4 w; w.x = cvtpk(a0[0], a0[1]); w.y = cvtpk(a0[2], a0[3]); w.z = cvtpk(a1[0], a1[1]); w.w = cvtpk(a1[2], a1[3]);
                    __builtin_amdgcn_raw_buffer_store_b128(w, rs, tid * 16, (((ai * 4 + m) * 2 + bj) * 512) * 16, 16); }
        asm volatile("s_waitcnt vmcnt(0)" ::: "memory"); PG8_BAR;
        unsigned* cnt = S.cnt + 32 * cur.tile;
        if (tid == 0) __hip_atomic_fetch_add(cnt, 1u, __ATOMIC_RELAXED, __HIP_MEMORY_SCOPE_AGENT);
        const int R = cur.S < 16 ? cur.S : 16;
        if (cur.s < R) {
            if (wid == 0) { unsigned polls = 0;
                while ((unsigned)__builtin_amdgcn_readfirstlane(__hip_atomic_load(cnt, __ATOMIC_RELAXED, __HIP_MEMORY_SCOPE_AGENT)) < (unsigned)cur.S) { __builtin_amdgcn_s_sleep(2); if (++polls > (1u << 22)) break; }
                __builtin_amdgcn_fence(__ATOMIC_ACQUIRE, "agent"); asm volatile("s_waitcnt vmcnt(0)" ::: "memory"); }
            asm volatile("" ::: "memory"); PG8_BAR; asm volatile("" ::: "memory");
            unsigned mask = 0u;
#pragma unroll
            for (int p = 0; p < 16; ++p) if ((p % R) == cur.s) { mask |= 1u << p;
                f32x4 s0 = (f32x4){0.f, 0.f, 0.f, 0.f}, s1 = (f32x4){0.f, 0.f, 0.f, 0.f};
                for (int s2 = 0; s2 < cur.S; s2 += 4) {
                    u32x4 v[4];
#pragma unroll
                    for (int j = 0; j < 4; ++j) { const int sj = (s2 + j < cur.S) ? s2 + j : cur.s;
                        const __amdgpu_buffer_rsrc_t rp = __builtin_amdgcn_make_buffer_rsrc((void*)(S.slab + (size_t)(cur.xw + 8 * sj * cur.rx) * SLAB_BYTES), (short)0, (int)SLAB_BYTES, 0x00020000);
                        v[j] = __builtin_amdgcn_raw_buffer_load_b128(rp, tid * 16, p * 512 * 16, 0); }
#pragma unroll
                    for (int j = 0; j < 4; ++j) if (s2 + j < cur.S) {
                        s0[0] += __uint_as_float(v[j].x << 16); s0[1] += __uint_as_float(v[j].x & 0xffff0000u); s0[2] += __uint_as_float(v[j].y << 16); s0[3] += __uint_as_float(v[j].y & 0xffff0000u);
                        s1[0] += __uint_as_float(v[j].z << 16); s1[1] += __uint_as_float(v[j].z & 0xffff0000u); s1[2] += __uint_as_float(v[j].w << 16); s1[3] += __uint_as_float(v[j].w & 0xffff0000u); } }
                acc[p >> 3][p & 1][(p >> 1) & 3][0] = s0; acc[p >> 3][p & 1][(p >> 1) & 3][1] = s1; }
            E(acc, cur, wr, wc, fr, fq, mask);
        }
    }
#undef PG8_SA
#undef PG8_SB
#undef PG8_STAGE
#undef PG8_LDA
#undef PG8_LDB
#undef PG8_MMA
#undef PG8_WAIT_V
#undef PG8_WAIT_L
#undef PG8_BAR
#undef PG8_SCHED
}
}
#define GAS __attribute__((address_space(1)))
#define LAS __attribute__((address_space(3)))
typedef unsigned short bf16;
typedef unsigned v4u __attribute__((ext_vector_type(4)));
typedef unsigned v2u __attribute__((ext_vector_type(2)));
typedef float f32x4 __attribute__((ext_vector_type(4)));
typedef short bf16x8 __attribute__((ext_vector_type(8)));
typedef short s16x4 __attribute__((ext_vector_type(4)));
typedef GAS unsigned gu32;
#define LDS_WAIT() asm volatile("s_waitcnt lgkmcnt(0)" ::: "memory")
#define VM_WAIT() asm volatile("s_waitcnt vmcnt(0)" ::: "memory")
using pg8::cvtpk;
__device__ __forceinline__ float bf_lo(unsigned w) { return __uint_as_float(w << 16); }
__device__ __forceinline__ float bf_hi(unsigned w) { return __uint_as_float(w & 0xffff0000u); }
__device__ __forceinline__ float wave_sum(float v) {
#pragma unroll
    for (int o = 1; o < 64; o <<= 1) v += __shfl_xor(v, o);
    return v;
}
__device__ __forceinline__ bf16x8 mk8(v4u a) { return __builtin_bit_cast(bf16x8, a); }
#define MFMA16(a, b, c) __builtin_amdgcn_mfma_f32_16x16x32_bf16((a), (b), (c), 0, 0, 0)
#define XB_TMO      128
#define XB_XCNT(j)  (256  + 64 * (j))
#define XB_XSUB(j)  (1280 + 64 * (j))
#define XB_XGEN(j)  (2304 + 64 * (j))
#define XB_TOP      3328
#define XB_TOPGEN   3392
#define XCD_BAR_WORDS 3456
#define XB_SPIN_CAP (1u << 18)

__device__ __forceinline__ unsigned xb_ld(unsigned* p)              { return __hip_atomic_load(p, __ATOMIC_RELAXED, __HIP_MEMORY_SCOPE_AGENT); }
__device__ __forceinline__ unsigned xb_add(unsigned* p, unsigned v) { return __hip_atomic_fetch_add(p, v, __ATOMIC_RELAXED, __HIP_MEMORY_SCOPE_AGENT); }
__device__ __forceinline__ unsigned xb_xcc_id() { return (unsigned)__builtin_amdgcn_s_getreg((3 << 11) | 20) & 0xFu; }
#define XB_SPIN(cond, bar) do { unsigned _sp = 0; while (cond) { __builtin_amdgcn_s_sleep(1); \
    if ((++_sp & 255u) == 0u) { if (xb_ld(&(bar)[XB_TMO])) break; if (_sp > XB_SPIN_CAP) { atomicAdd(&(bar)[XB_TMO], 1u); break; } } } } while (0)

struct XcdBarrier {
    unsigned* bar; unsigned x;
    volatile LAS unsigned* st;
};

__device__ __forceinline__ XcdBarrier xcd_barrier_post(unsigned* bar, volatile LAS unsigned* st) {
    XcdBarrier b; b.bar = bar; b.x = xb_xcc_id(); b.st = st;
    if (threadIdx.x == 0) (void)xb_add(&bar[XB_XCNT(b.x)], 1u);
    return b;
}
__device__ __forceinline__ void xcd_barrier_complete(unsigned* bar, unsigned x, unsigned& nloc, unsigned& nx) {
    const unsigned G = gridDim.x * gridDim.y * gridDim.z;
    unsigned sum, cnt, mine, sp = 0u;
    for (;;) {
        sum = 0u; cnt = 0u; mine = 0u;
#pragma unroll
        for (unsigned j = 0; j < 16; ++j) { const unsigned c = xb_ld(&bar[XB_XCNT(j)]); sum += c; cnt += (c > 0u) ? 1u : 0u; mine = (j == x) ? c : mine; }
        if (sum == G) break;
        __builtin_amdgcn_s_sleep(1);
        if ((++sp & 255u) == 0u) { if (xb_ld(&bar[XB_TMO])) break; if (sp > XB_SPIN_CAP) { atomicAdd(&bar[XB_TMO], 1u); break; } }
    }
    nloc = mine > 0u ? mine : 1u; nx = cnt > 0u ? cnt : 1u;
}

__device__ __forceinline__ void xcd_barrier(const XcdBarrier& b) {
    asm volatile("s_waitcnt vmcnt(0)" ::: "memory");
    __syncthreads();
    if (threadIdx.x == 0) {
        unsigned* bar = b.bar;
        __builtin_amdgcn_s_waitcnt(0);
        unsigned nloc = b.st[0], nx = b.st[1];
        if (nloc == 0u) { xcd_barrier_complete(bar, b.x, nloc, nx); b.st[0] = nloc; b.st[1] = nx; }
        const unsigned old = xb_add(&bar[XB_XSUB(b.x)], 1u);
        const unsigned gen = old / nloc;
        if (old + 1u == (gen + 1u) * nloc) {
            __builtin_amdgcn_fence(__ATOMIC_RELEASE, "agent");
            asm volatile("s_waitcnt vmcnt(0)" ::: "memory");
            const unsigned og = xb_add(&bar[XB_TOP], 1u);
            const unsigned tg = og / nx;
            if (og + 1u == (tg + 1u) * nx) xb_add(&bar[XB_TOPGEN], 1u);
            else XB_SPIN(xb_ld(&bar[XB_TOPGEN]) == tg, bar);
            __builtin_amdgcn_fence(__ATOMIC_ACQUIRE, "agent");
            xb_add(&bar[XB_XGEN(b.x)], 1u);
            asm volatile("s_waitcnt vmcnt(0)" ::: "memory");
        } else {
            XB_SPIN(xb_ld(&bar[XB_XGEN(b.x)]) == gen, bar);
            __builtin_amdgcn_fence(__ATOMIC_ACQUIRE, "agent");
            asm volatile("s_waitcnt vmcnt(0)" ::: "memory");
        }
    }
    __syncthreads();
}

struct Args { const float* in[27]; float* out; unsigned char* ws; int ph_lo, ph_hi; };
struct Frame {
    LAS unsigned char* lds; volatile LAS unsigned* MISC;
    int tid, lane, wave, vcu, G;
    const Args* a;
};
#define A_IN(k) (F.a->in[k])
#define A_WS(T, off) ((T*)(F.a->ws + (off)))
#define A_OUT (F.a->out)
#define A_XF (F.a->out + OUT_Y)
#define A_SSQ(k) ((unsigned long long*)(F.a->ws + CTL_SSQ_BYTE) + (size_t)(k) * M)

template <bool F8>
__device__ __forceinline__ void p0_load(const float* W, int ldn, const float* gain, int k0, int n0, int lane, f32x4 (&va)[8], f32x4 (&vb)[8], float (&ga)[8], float (&gb)[8]) {
    const int nq = lane & 15, kr = lane >> 4; const float gsc = F8 ? 64.f : 1.f;
#pragma unroll
    for (int j = 0; j < 8; ++j) { const int ka = k0 + 8 * j + 2 * kr;
        va[j] = *(const f32x4*)(W + (size_t)ka * ldn + n0 + 4 * nq); vb[j] = *(const f32x4*)(W + (size_t)(ka + 1) * ldn + n0 + 4 * nq);
        ga[j] = gain ? gain[ka] * gsc : gsc; gb[j] = gain ? gain[ka + 1] * gsc : gsc; }
}
template <int MODE, bool F8>
__device__ __forceinline__ void p0_store(int ldk, bf16* WT, LAS unsigned char* scr, int k0, int n0, int lane, const f32x4 (&va)[8], const f32x4 (&vb)[8], const float (&ga)[8], const float (&gb)[8]) {
    const int nq = lane & 15, kr = lane >> 4;
#pragma unroll
    for (int j = 0; j < 8; ++j)
#pragma unroll
        for (int e = 0; e < 4; ++e) *(LAS unsigned*)(scr + (4 * nq + e) * 128 + ((j ^ (nq & 7)) << 4) + 4 * kr) = cvtpk(va[j][e] * ga[j], vb[j][e] * gb[j]);
    LDS_WAIT(); asm volatile("" ::: "memory");
#pragma unroll
    for (int i = 0; i < 8; ++i) {
        const int n = (lane >> 3) + 8 * i, c = lane & 7;
        const v4u o = *(const LAS v4u*)(scr + n * 128 + ((c ^ ((n >> 2) & 7)) << 4));
        const int nn = n0 + n;
        const int r = (MODE == 0) ? nn : (32 * (nn >> 4) + (nn & 15) + (MODE == 2 ? 16 : 0));
        if constexpr (F8) { v2u q; q.x = pg8::pack4_fp8(bf_lo(o.x), bf_hi(o.x), bf_lo(o.y), bf_hi(o.y)); q.y = pg8::pack4_fp8(bf_lo(o.z), bf_hi(o.z), bf_lo(o.w), bf_hi(o.w));
            *(v2u*)((unsigned char*)WT + (size_t)r * ldk + k0 + 8 * c) = q; }
        else *(v4u*)(WT + (size_t)r * ldk + k0 + 8 * c) = o;
    }
    LDS_WAIT(); asm volatile("" ::: "memory");
}
template <int MODE, bool F8 = false>
__device__ __forceinline__ void p0_matrix(Frame& F, const float* W, int K, int ldn, int ncols, const float* gain, bf16* WT, int gw, int NGW) {
    LAS unsigned char* scr = F.lds + F.wave * 18432;
    const int ntn = ncols / 64, nt = (K / 64) * ntn;
    const int ldk = (K == D) ? LDX : (K == FFN ? LDH : K);
    for (int it = 2 * gw; it < nt; it += 2 * NGW) { const int it2 = it + 1;
        f32x4 va[8], vb[8], wa[8], wb[8]; float ga[8], gb[8], ha[8], hb[8];
        p0_load<F8>(W, ldn, gain, (it / ntn) * 64, (it % ntn) * 64, F.lane, va, vb, ga, gb);
        if (it2 < nt) p0_load<F8>(W, ldn, gain, (it2 / ntn) * 64, (it2 % ntn) * 64, F.lane, wa, wb, ha, hb);
        p0_store<MODE, F8>(ldk, WT, scr, (it / ntn) * 64, (it % ntn) * 64, F.lane, va, vb, ga, gb);
        if (it2 < nt) p0_store<MODE, F8>(ldk, WT, scr, (it2 / ntn) * 64, (it2 % ntn) * 64, F.lane, wa, wb, ha, hb); }
}
__device__ __forceinline__ void p0_late_weights(Frame& F, int gw, int NGW, int gwo, int NGWO) {
    if (gwo >= 0) p0_matrix<0>(F, A_IN(18), D, D, D, nullptr, A_WS(bf16, WS_WOUT), gwo, NGWO);
    p0_matrix<1, true>(F, A_IN(20), D, FFN, FFN, A_IN(19), A_WS(bf16, WS_W2GU), gw, NGW);
    p0_matrix<2, true>(F, A_IN(21), D, FFN, FFN, A_IN(19), A_WS(bf16, WS_W2GU), gw, NGW);
    p0_matrix<0, true>(F, A_IN(22), FFN, D, D, nullptr, A_WS(bf16, WS_W2D), gw, NGW);
}
__device__ __forceinline__ void p0_ple_weights(Frame& F, int gw, int NGW) {
    p0_matrix<0, true>(F, A_IN(24), D, D, D, A_IN(23), A_WS(bf16, WS_WPG), gw, NGW);
}
__device__ __forceinline__ void p0_prologue(Frame& F) {
    const int gw = F.vcu * NWAVES + F.wave, NGW = F.G * NWAVES;
    p0_matrix<1>(F, A_IN(10), D, FFN, FFN, A_IN(9), A_WS(bf16, WS_W1GU), gw, NGW);
    p0_matrix<2>(F, A_IN(11), D, FFN, FFN, A_IN(9), A_WS(bf16, WS_W1GU), gw, NGW);
    p0_matrix<0>(F, A_IN(12), FFN, D, D, nullptr, A_WS(bf16, WS_W1D), gw, NGW);
    p0_matrix<0>(F, A_IN(14), D, NINF, NIN, A_IN(13), A_WS(bf16, WS_WIN), gw, NGW);
    p0_matrix<0>(F, A_IN(25), PLE, D, D, nullptr, A_WS(bf16, WS_WPP), gw, NGW);
    for (int row = gw; row < M; row += NGW) {
        const float* src = row < MP ? A_IN(0) + (size_t)row * D : A_IN(1) + (size_t)(row - MP) * D;
        const f32x4* xr = (const f32x4*)src + F.lane; v2u* o = (v2u*)(A_WS(bf16, WS_XB) + (size_t)row * LDX) + F.lane; float s = 0.f;
#pragma unroll
        for (int j = 0; j < 16; ++j) { const f32x4 v = xr[64 * j]; s += (v[0] * v[0] + v[1] * v[1]) + (v[2] * v[2] + v[3] * v[3]); v2u w; w.x = cvtpk(v[0], v[1]); w.y = cvtpk(v[2], v[3]); o[64 * j] = w; }
        s = wave_sum(s);
        if (F.lane == 0) A_SSQ(0)[row] = pg8::ssq_fix(s);
    }
    const int gt = F.vcu * NWAVES * 64 + F.tid, NGT = F.G * NWAVES * 64;
    for (int i = gt; i < M * (PLE / 4); i += NGT) {
        const f32x4 v = (i < MP * (PLE / 4)) ? ((const f32x4*)A_IN(7))[i] : ((const f32x4*)A_IN(8))[i - MP * (PLE / 4)];
        v2u w; w.x = cvtpk(v[0], v[1]); w.y = cvtpk(v[2], v[3]); ((v2u*)A_WS(bf16, WS_PB))[i] = w;
    }
    for (int i = gt; i < 8 * D; i += NGT) { const int j = i / D, k = i % D; A_WS(float, WS_WIF)[i] = A_IN(13)[k] * A_IN(14)[(size_t)k * NINF + NIN + j]; }
}

__device__ __forceinline__ void gates_rows(Frame& F) {
    const int gw = F.vcu * NWAVES + F.wave, NGW = F.G * NWAVES;
    float acc[5][8];
#pragma unroll
    for (int r = 0; r < 5; ++r)
#pragma unroll
        for (int jj = 0; jj < 8; ++jj) acc[r][jj] = 0.f;
    for (int j = 0; j < 16; ++j) {
        f32x4 wv[8];
#pragma unroll
        for (int jj = 0; jj < 8; ++jj) wv[jj] = *(const f32x4*)(A_WS(float, WS_WIF) + jj * D + 256 * j + 4 * F.lane);
#pragma unroll
        for (int r = 0; r < 5; ++r) { const int row = gw + NGW * r;
            if (row < M) { const v2u xw = *(const v2u*)(A_WS(bf16, WS_XB) + (size_t)row * D + 256 * j + 4 * F.lane); f32x4 x; x[0] = bf_lo(xw.x); x[1] = bf_hi(xw.x); x[2] = bf_lo(xw.y); x[3] = bf_hi(xw.y);
#pragma unroll
                for (int jj = 0; jj < 8; ++jj) acc[r][jj] += (x[0] * wv[jj][0] + x[1] * wv[jj][1]) + (x[2] * wv[jj][2] + x[3] * wv[jj][3]); } }
    }
#pragma unroll
    for (int r = 0; r < 5; ++r) { const int row = gw + NGW * r;
        if (row < M) { const float rs = pg8::rs_of(A_SSQ(1), row);
#pragma unroll
            for (int jj = 0; jj < 8; ++jj) { const float s = wave_sum(acc[r][jj]); if (F.lane == jj) A_WS(float, WS_GATES)[(size_t)row * 8 + jj] = s * rs + A_IN(15)[jj]; } } }
}

__device__ __forceinline__ bf16x8 cvt8(const f32x4 a, const f32x4 b) { v4u w; w.x = cvtpk(a[0], a[1]); w.y = cvtpk(a[2], a[3]); w.z = cvtpk(b[0], b[1]); w.w = cvtpk(b[2], b[3]); return mk8(w); }
__device__ __forceinline__ s16x4 tr16(LAS unsigned char* p) { typedef short v4i16_t __attribute__((ext_vector_type(4))); return __builtin_bit_cast(s16x4, __builtin_amdgcn_ds_read_tr16_b64_v4i16((LAS v4i16_t*)p)); }
constexpr int SB_VLD = 288, SB_VBYTES = 64 * SB_VLD;
__device__ __forceinline__ void sb_unit(Frame& F, int unit, LAS unsigned char* vl) {
    const int lane = F.lane, i16 = lane & 15, g = lane >> 4;
    const int h = unit & 15, qrow0 = (unit >> 4) * 16;
    const bool samp = qrow0 >= MP;
    int pos0, krow_base; const float* ck = nullptr; const float* cv = nullptr;
    if (!samp) { pos0 = qrow0 & (SEQ - 1); krow_base = qrow0 - pos0; }
    else { const int bs = (qrow0 - MP) >> 5; pos0 = PAST + ((qrow0 - MP) & 31); krow_base = MP + bs * DSEQ - PAST;
           ck = A_IN(2) + (size_t)bs * PAST * SBW + h * SBD; cv = A_IN(3) + (size_t)bs * PAST * SBW + h * SBD; }
    const int qpos = pos0 + i16;
    bf16x8 qf[4];
#pragma unroll
    for (int ks = 0; ks < 4; ++ks) qf[ks] = *(const bf16x8*)(A_WS(bf16, WS_QB) + (size_t)(qrow0 + i16) * SBW + h * SBD + 32 * ks + 8 * g);
    f32x4 o[8];
#pragma unroll
    for (int d = 0; d < 8; ++d) o[d] = (f32x4){0.f, 0.f, 0.f, 0.f};
    float P = 1.0f;
    for (int kend = pos0 + 16; kend > 0; kend -= 64) {
        const int kbase = kend - 64;
        f32x4 beta[4], omb[4];
        if (!samp) {
            v4u vv[16]; bf16x8 kf[4][4];
#pragma unroll
            for (int i = 0; i < 16; ++i) { const int key = (lane >> 4) + 4 * i, dc = lane & 15; int pos = kbase + key; pos = pos < 0 ? 0 : pos;
                vv[i] = *(const v4u*)(A_WS(bf16, WS_VB) + (size_t)(krow_base + pos) * SBW + h * SBD + 8 * dc); }
#pragma unroll
            for (int kt = 0; kt < 4; ++kt) { int t0 = kbase + 16 * kt; t0 = t0 < 0 ? 0 : t0;
#pragma unroll
                for (int ks = 0; ks < 4; ++ks) kf[kt][ks] = *(const bf16x8*)(A_WS(bf16, WS_KB) + (size_t)(krow_base + t0 + i16) * SBW + h * SBD + 32 * ks + 8 * g); }
#pragma unroll
            for (int i = 0; i < 16; ++i) { const int key = (lane >> 4) + 4 * i, dc = lane & 15; *(LAS v4u*)(vl + key * SB_VLD + dc * 16) = vv[i]; }
#pragma unroll
            for (int kt = 0; kt < 4; ++kt) { const int t0 = kbase + 16 * kt;
                f32x4 acc = (f32x4){0.f, 0.f, 0.f, 0.f};
#pragma unroll
                for (int ks = 0; ks < 4; ++ks) acc = MFMA16(kf[kt][ks], qf[ks], acc);
#pragma unroll
                for (int r = 0; r < 4; ++r) { const float z = acc[r]; const float e = __expf(-fabsf(z)); const float rr = __builtin_amdgcn_rcpf(1.0f + e), er = e * rr;
                    const bool ok = t0 >= 0 && (t0 + 4 * g + r) < qpos;
                    beta[kt][r] = ok ? (z >= 0.f ? rr : er) : 0.f; omb[kt][r] = ok ? (z >= 0.f ? er : rr) : 1.f; } }
        } else {
#pragma unroll
        for (int i = 0; i < 16; ++i) {
            const int key = (lane >> 4) + 4 * i, dc = lane & 15; int pos = kbase + key; pos = pos < 0 ? 0 : pos;
            v4u val;
            if (samp && (kbase + 4 * i) < PAST) { const float* p = cv + (size_t)pos * SBW + 8 * dc; const f32x4 a = *(const f32x4*)p, b = *(const f32x4*)(p + 4); val = __builtin_bit_cast(v4u, cvt8(a, b)); }
            else val = *(const v4u*)(A_WS(bf16, WS_VB) + (size_t)(krow_base + pos) * SBW + h * SBD + 8 * dc);
            *(LAS v4u*)(vl + key * SB_VLD + dc * 16) = val;
        }
#pragma unroll
        for (int kt = 0; kt < 4; ++kt) {
            const int t0 = kbase + 16 * kt;
            if (t0 < 0) { beta[kt] = (f32x4){0.f, 0.f, 0.f, 0.f}; omb[kt] = (f32x4){1.f, 1.f, 1.f, 1.f}; continue; }
            f32x4 acc = (f32x4){0.f, 0.f, 0.f, 0.f};
            if (samp && t0 < PAST) {
#pragma unroll
                for (int ks = 0; ks < 4; ++ks) { const float* p = ck + (size_t)(t0 + i16) * SBW + 32 * ks + 8 * g; const f32x4 a = *(const f32x4*)p, b = *(const f32x4*)(p + 4);
                    acc = MFMA16(cvt8(a, b), qf[ks], acc); }
            } else {
#pragma unroll
                for (int ks = 0; ks < 4; ++ks) { const bf16x8 kf = *(const bf16x8*)(A_WS(bf16, WS_KB) + (size_t)(krow_base + t0 + i16) * SBW + h * SBD + 32 * ks + 8 * g); acc = MFMA16(kf, qf[ks], acc); }
            }
#pragma unroll
            for (int r = 0; r < 4; ++r) { const float z = acc[r]; const float e = __expf(-fabsf(z)); const float rr = __builtin_amdgcn_rcpf(1.0f + e), er = e * rr;
                const bool ok = (t0 + 4 * g + r) < qpos;
                beta[kt][r] = ok ? (z >= 0.f ? rr : er) : 0.f; omb[kt][r] = ok ? (z >= 0.f ? er : rr) : 1.f; }
        }
        }
        f32x4 a[4]; float Pc = P;
#pragma unroll
        for (int kt = 3; kt >= 0; --kt) {
            const float s2 = omb[kt][3], s1 = s2 * omb[kt][2], s0 = s1 * omb[kt][1], T = s0 * omb[kt][0];
            const float x1 = __shfl_xor(T, 16), x2 = __shfl_xor(T, 32), x3 = __shfl_xor(T, 48);
            const float Sg = (((g ^ 1) > g) ? x1 : 1.f) * (((g ^ 2) > g) ? x2 : 1.f) * (((g ^ 3) > g) ? x3 : 1.f);
            const float base = Sg * Pc;
            a[kt][0] = beta[kt][0] * s0 * base; a[kt][1] = beta[kt][1] * s1 * base; a[kt][2] = beta[kt][2] * s2 * base; a[kt][3] = beta[kt][3] * base;
            Pc *= (T * x1) * (x2 * x3);
        }
        P = Pc;
#pragma unroll
        for (int ks2 = 0; ks2 < 2; ++ks2) {
            const bf16x8 af = cvt8(a[2 * ks2], a[2 * ks2 + 1]);
#pragma unroll
            for (int d = 0; d < 8; ++d) {
                LAS unsigned char* p = vl + (32 * ks2 + 4 * g + (i16 >> 2)) * SB_VLD + (16 * d + 4 * (i16 & 3)) * 2;
                const s16x4 lo = tr16(p), hi = tr16(p + 16 * SB_VLD);
                const bf16x8 vf = __builtin_shufflevector(lo, hi, 0, 1, 2, 3, 4, 5, 6, 7);
                o[d] = MFMA16(vf, af, o[d]);
            }
        }
        if (__all(P < 7.8886090522101181e-31f)) break;
    }
    float ss = 0.f;
#pragma unroll
    for (int d = 0; d < 8; ++d) ss += (o[d][0] * o[d][0] + o[d][1] * o[d][1]) + (o[d][2] * o[d][2] + o[d][3] * o[d][3]);
    ss += __shfl_xor(ss, 16); ss += __shfl_xor(ss, 32);
    const float rinv = rsqrtf(ss * (1.0f / SBD) + EPS);
    bf16* mrow = A_WS(bf16, WS_MIX) + (size_t)(qrow0 + i16) * LDX + h * SBD + 4 * g;
#pragma unroll
    for (int d = 0; d < 8; ++d) { const f32x4 gv = *(const f32x4*)(A_IN(16) + h * SBD + 16 * d + 4 * g);
        v2u w; w.x = cvtpk(o[d][0] * rinv * gv[0], o[d][1] * rinv * gv[1]); w.y = cvtpk(o[d][2] * rinv * gv[2], o[d][3] * rinv * gv[3]); *(v2u*)(mrow + 16 * d) = w; }
}

constexpr int ML_QS = 0, ML_LD = 528, ML_KS = 33792, ML_TLD = 144, ML_VS = 67584, ML_VSS = 76800, ML_PS = 86016, ML_TAB = 95232;
__device__ __forceinline__ float scan_add(float v, int lane) {
#pragma unroll
    for (int o = 1; o < 64; o <<= 1) { const float t = __shfl_up(v, o); v = (lane >= o) ? v + t : v; }
    return v;
}
__device__ __forceinline__ float scan_max(float v, int lane) {
#pragma unroll
    for (int o = 1; o < 64; o <<= 1) { const float t = __shfl_up(v, o); v = (lane >= o) ? fmaxf(v, t) : v; }
    return v;
}
__device__ __forceinline__ void mlstm_scan(Frame& F, int seq, int h, int vblk, bool samp, bool doval, bool doden) {
    LAS unsigned char* L = F.lds; const int tid = F.tid, lane = F.lane, w = F.wave, i16 = lane & 15, g = lane >> 4;
    const int nsteps = samp ? 1 : SEQ / CHUNK, Lvalid = samp ? DSEQ : CHUNK;
    const int row0 = samp ? MP + seq * DSEQ : seq * SEQ, vbase = vblk * 64; const bool vw = w < 4;
    LAS float* tab = (LAS float*)(L + ML_TAB); LAS float* nvec = tab + 192; LAS float* dpart = tab + 448; LAS float* rsp = tab + 960;
    f32x4 C[16]; float m;
    if (samp) { const float* c0 = A_IN(4) + ((size_t)(seq * MLH + h) * MLV + vbase + 16 * (w & 3) + i16) * MLQK + 4 * g;
#pragma unroll
        for (int dt = 0; dt < 16; ++dt) C[dt] = *(const f32x4*)(c0 + 16 * dt);
        m = A_IN(6)[seq * MLH + h]; if (tid < MLQK) nvec[tid] = A_IN(5)[(seq * MLH + h) * MLQK + tid]; }
    else {
#pragma unroll
        for (int dt = 0; dt < 16; ++dt) C[dt] = (f32x4){0.f, 0.f, 0.f, 0.f};
        m = 0.f; if (tid < MLQK) nvec[tid] = 0.f; }
    v4u qreg[4], kreg[4], vreg; f32x4 sc4; float aav, wprev_n;
#define ML_PREFETCH(cc) do { const int rowc_ = row0 + CHUNK * (cc); \
        _Pragma("unroll") for (int i = 0; i < 4; ++i) { const int id = tid + 512 * i, r = id >> 5, c16 = id & 31; \
            if (r < Lvalid) { qreg[i] = *(const v4u*)(A_WS(bf16, WS_MQ) + (size_t)(rowc_ + r) * 1024 + h * MLQK + 8 * c16); kreg[i] = *(const v4u*)(A_WS(bf16, WS_MK) + (size_t)(rowc_ + r) * 1024 + h * MLQK + 8 * c16); } \
            else { qreg[i] = (v4u){0u, 0u, 0u, 0u}; kreg[i] = (v4u){0u, 0u, 0u, 0u}; } } \
        { const int r = tid >> 3, c8 = tid & 7; \
            if (r < Lvalid) vreg = *(const v4u*)(A_WS(bf16, WS_MV) + (size_t)(rowc_ + r) * 2048 + h * MLV + vbase + 8 * c8); else vreg = (v4u){0u, 0u, 0u, 0u}; } \
        sc4 = *(const f32x4*)(GS + ((size_t)(cc) * 64 + lane) * 4); aav = GS[16384 + (cc) * 64 + lane]; wprev_n = GS[20480 + (cc)]; } while (0)
    float* GS = A_WS(float, WS_MLS) + (size_t)blockIdx.x * 21504;
    {   LAS float* ptab = (LAS float*)(L + ML_QS);
        float pb[8], pa[8], pA[8];
#pragma unroll
        for (int k = 0; k < 8; ++k) { const int cc = w + 8 * k; pb[k] = 0.f; pa[k] = -INFINITY; pA[k] = -INFINITY;
            if (cc < nsteps) { float gi, gf; const int rowc_ = row0 + CHUNK * cc;
                if (lane < Lvalid) { gi = A_WS(float, WS_GATES)[(size_t)(rowc_ + lane) * 8 + h]; gf = A_WS(float, WS_GATES)[(size_t)(rowc_ + lane) * 8 + 4 + h]; } else { gi = -INFINITY; gf = 1e30f; }
                const float lf = fminf(gf, 0.f) - log1pf(expf(-fabsf(gf)));
                pb[k] = scan_add(lf, lane); pa[k] = gi - pb[k]; pA[k] = scan_max(pa[k], lane);
                if (lane == Lvalid - 1) { ptab[2 * cc] = pb[k]; ptab[2 * cc + 1] = pA[k]; } } }
        __syncthreads();
        const float Bc = lane < nsteps ? ptab[2 * lane] : 0.f, Ac = lane < nsteps ? ptab[2 * lane + 1] : -INFINITY;
        float mcur = m, mstart = m, mend = m;
        for (int cc = 0; cc < nsteps; ++cc) { const float mn = __shfl(Bc, cc) + fmaxf(mcur, __shfl(Ac, cc)); if (lane == cc) { mstart = mcur; mend = mn; } mcur = mn; }
        m = mcur;
#pragma unroll
        for (int k = 0; k < 8; ++k) { const int cc = w + 8 * k;
            if (cc < nsteps) { const float mc = __shfl(mstart, cc), mnew = __shfl(mend, cc), blast = __shfl(pb[k], Lvalid - 1);
                const float mrow = pb[k] + fmaxf(mc, pA[k]);
                f32x4 o; o[0] = expf(blast + pa[k] - mnew); o[1] = expf(pb[k] + mc - mrow); o[2] = expf(-mrow); o[3] = pb[k] - mrow;
                *(f32x4*)(GS + ((size_t)cc * 64 + lane) * 4) = o; GS[16384 + cc * 64 + lane] = pa[k];
                if (lane == 0) GS[20480 + cc] = expf(blast + mc - mnew); } }
        asm volatile("s_waitcnt vmcnt(0)" ::: "memory");
        __syncthreads(); }
    ML_PREFETCH(0);
    for (int c = 0; c < nsteps; ++c) {
        const int rowc = row0 + CHUNK * c;
        const float wtok = sc4[0], winter = sc4[1], emr = sc4[2], uu = sc4[3], aa = aav, wprev = wprev_n;
#pragma unroll
        for (int i = 0; i < 4; ++i) { const int id = tid + 512 * i, r = id >> 5, c16 = id & 31; *(LAS v4u*)(L + ML_QS + r * ML_LD + c16 * 16) = qreg[i]; *(LAS v4u*)(L + ML_KS + r * ML_LD + c16 * 16) = kreg[i]; }
        { const int r = tid >> 3, c8 = tid & 7; const float wt = __shfl(wtok, r);
            *(LAS v4u*)(L + ML_VS + r * ML_TLD + c8 * 16) = vreg;
            v4u sv; sv.x = cvtpk(bf_lo(vreg.x) * wt, bf_hi(vreg.x) * wt); sv.y = cvtpk(bf_lo(vreg.y) * wt, bf_hi(vreg.y) * wt); sv.z = cvtpk(bf_lo(vreg.z) * wt, bf_hi(vreg.z) * wt); sv.w = cvtpk(bf_lo(vreg.w) * wt, bf_hi(vreg.w) * wt);
            *(LAS v4u*)(L + ML_VSS + r * ML_TLD + c8 * 16) = sv; }
        if (w == 0) { tab[lane] = wtok; tab[64 + lane] = winter; tab[128 + lane] = emr; tab[1088 + lane] = uu; tab[1152 + lane] = aa; }
        if (c + 1 < nsteps) ML_PREFETCH(c + 1);
        __syncthreads();
#define SB0() __builtin_amdgcn_sched_barrier(0)
        {   if (!vw) { const int tt = w - 4; float rsum = 0.f; const float ut = tab[1088 + 16 * tt + i16];
            bf16x8 fq[8];
#pragma unroll
            for (int ks = 0; ks < 8; ++ks) fq[ks] = *(const LAS bf16x8*)(L + ML_QS + (16 * tt + i16) * ML_LD + (32 * ks + 8 * g) * 2);
#pragma unroll
            for (int st = 0; st < 4; ++st) { f32x4 acc = (f32x4){0.f, 0.f, 0.f, 0.f};
                if (st <= tt) { bf16x8 fk[8];
#pragma unroll
                    for (int ks = 0; ks < 8; ++ks) fk[ks] = *(const LAS bf16x8*)(L + ML_KS + (16 * st + i16) * ML_LD + (32 * ks + 8 * g) * 2);
                    SB0();
#pragma unroll
                    for (int ks = 0; ks < 8; ++ks) acc = MFMA16(fk[ks], fq[ks], acc);
                    SB0(); }
                f32x4 pv; const f32x4 as4 = *(const LAS f32x4*)(tab + 1152 + 16 * st + 4 * g);
#pragma unroll
                for (int r = 0; r < 4; ++r) { const float as = as4[r]; const bool ok = (st < tt) || (st == tt && (4 * g + r) <= i16); pv[r] = ok ? acc[r] * __expf(ut + as) : 0.f; }
                rsum += (pv[0] + pv[1]) + (pv[2] + pv[3]);
                v2u pw; pw.x = cvtpk(pv[0], pv[1]); pw.y = cvtpk(pv[2], pv[3]); *(LAS v2u*)(L + ML_PS + (16 * tt + i16) * ML_TLD + (16 * st + 4 * g) * 2) = pw; }
            rsum += __shfl_xor(rsum, 16); rsum += __shfl_xor(rsum, 32);
            if (g == 0) { rsp[(16 * tt + i16) * 2] = rsum; rsp[(16 * tt + i16) * 2 + 1] = 0.f; } }
            if (doden) { float dp = 0.f; v4u qq[4]; f32x4 nn0[4], nn1[4];
#pragma unroll
            for (int c4 = 0; c4 < 4; ++c4) { qq[c4] = *(const LAS v4u*)(L + ML_QS + lane * ML_LD + (32 * w + 8 * c4) * 2); nn0[c4] = *(const LAS f32x4*)(nvec + 32 * w + 8 * c4); nn1[c4] = *(const LAS f32x4*)(nvec + 32 * w + 8 * c4 + 4); }
#pragma unroll
            for (int c4 = 0; c4 < 4; ++c4) dp += (bf_lo(qq[c4].x) * nn0[c4][0] + bf_hi(qq[c4].x) * nn0[c4][1]) + (bf_lo(qq[c4].y) * nn0[c4][2] + bf_hi(qq[c4].y) * nn0[c4][3]) + (bf_lo(qq[c4].z) * nn1[c4][0] + bf_hi(qq[c4].z) * nn1[c4][1]) + (bf_lo(qq[c4].w) * nn1[c4][2] + bf_hi(qq[c4].w) * nn1[c4][3]);
            dpart[lane * 8 + w] = dp; } }
        f32x4 Y[4];
#pragma unroll
        for (int t2 = 0; t2 < 4; ++t2) Y[t2] = (f32x4){0.f, 0.f, 0.f, 0.f};
        if (vw && doval) {
#define ML_LDQ(dst, ks_) do { _Pragma("unroll") for (int t2 = 0; t2 < 4; ++t2) { const LAS unsigned char* qp = L + ML_QS + (16 * t2 + i16) * ML_LD + (32 * (ks_) + 4 * g) * 2; const v2u b0 = *(const LAS v2u*)qp, b1 = *(const LAS v2u*)(qp + 32); \
            dst[t2].x = b0.x; dst[t2].y = b0.y; dst[t2].z = b1.x; dst[t2].w = b1.y; } } while (0)
        v4u qa[4], qb[4];
        ML_LDQ(qa, 0);
#pragma unroll
        for (int ks = 0; ks < 8; ks += 2) {
            ML_LDQ(qb, ks + 1); SB0();
            { const bf16x8 af = cvt8(C[2 * ks], C[2 * ks + 1]);
#pragma unroll
              for (int t2 = 0; t2 < 4; ++t2) Y[t2] = MFMA16(af, mk8(qa[t2]), Y[t2]); }
            SB0();
            if (ks + 2 < 8) ML_LDQ(qa, ks + 2);
            SB0();
            { const bf16x8 af = cvt8(C[2 * ks + 2], C[2 * ks + 3]);
#pragma unroll
              for (int t2 = 0; t2 < 4; ++t2) Y[t2] = MFMA16(af, mk8(qb[t2]), Y[t2]); }
            SB0(); }
#undef ML_LDQ
#pragma unroll
        for (int t2 = 0; t2 < 4; ++t2) Y[t2] = Y[t2] * tab[64 + 16 * t2 + i16];
#pragma unroll
        for (int dt = 0; dt < 16; ++dt) C[dt] = C[dt] * wprev;
#pragma unroll
        for (int ks = 0; ks < 2; ++ks) { LAS unsigned char* tp = L + (32 * ks + 8 * g + (i16 >> 2)) * ML_TLD + (16 * w + 4 * (i16 & 3)) * 2;
            LAS unsigned char* kp = L + ML_KS + (32 * ks + 8 * g + (i16 >> 2)) * ML_LD + (4 * (i16 & 3)) * 2;
            const s16x4 blo = tr16(tp + ML_VSS), bhi = tr16(tp + ML_VSS + 4 * ML_TLD);
            const bf16x8 B = __builtin_shufflevector(blo, bhi, 0, 1, 2, 3, 4, 5, 6, 7);
#pragma unroll
            for (int dh = 0; dh < 16; dh += 8) { s16x4 alo[8], ahi[8];
#pragma unroll
                for (int dt = 0; dt < 8; ++dt) { alo[dt] = tr16(kp + 32 * (dh + dt)); ahi[dt] = tr16(kp + 32 * (dh + dt) + 4 * ML_LD); }
                SB0();
#pragma unroll
                for (int dt = 0; dt < 8; ++dt) { const bf16x8 A = __builtin_shufflevector(alo[dt], ahi[dt], 0, 1, 2, 3, 4, 5, 6, 7); C[dh + dt] = MFMA16(A, B, C[dh + dt]); }
                SB0(); } }
        }
        __syncthreads();
        if (vw && doval) {
            s16x4 alo[2], ahi[2]; bf16x8 pb[2][4];
#pragma unroll
            for (int ks = 0; ks < 2; ++ks) { LAS unsigned char* tp = L + ML_VS + (32 * ks + 8 * g + (i16 >> 2)) * ML_TLD + (16 * w + 4 * (i16 & 3)) * 2; alo[ks] = tr16(tp); ahi[ks] = tr16(tp + 4 * ML_TLD);
#pragma unroll
                for (int t2 = 0; t2 < 4; ++t2) pb[ks][t2] = *(const LAS bf16x8*)(L + ML_PS + (16 * t2 + i16) * ML_TLD + (32 * ks + 8 * g) * 2); }
            SB0();
#pragma unroll
            for (int ks = 0; ks < 2; ++ks) { const bf16x8 A = __builtin_shufflevector(alo[ks], ahi[ks], 0, 1, 2, 3, 4, 5, 6, 7);
#pragma unroll
                for (int t2 = 0; t2 < 4; ++t2) Y[t2] = MFMA16(A, pb[ks][t2], Y[t2]); }
            SB0();
#pragma unroll
        for (int t2 = 0; t2 < 4; ++t2) { const int t = 16 * t2 + i16; if (t < Lvalid) *(f32x4*)(A_WS(float, WS_NUM) + (size_t)(rowc + t) * 2048 + h * MLV + vbase + 16 * w + 4 * g) = Y[t2]; }
        }
        if (doden) { if (tid < CHUNK) { float dq = 0.f;
#pragma unroll
            for (int j = 0; j < 8; ++j) dq += dpart[tid * 8 + j];
            const float den = tab[64 + tid] * dq + rsp[2 * tid] + rsp[2 * tid + 1]; const float dd = fmaxf(fabsf(den), tab[128 + tid]);
            if (tid < Lvalid) A_WS(float, WS_DEN)[(size_t)(rowc + tid) * MLH + h] = dd; }
#pragma unroll
        for (int dd2 = 0; dd2 < 2; ++dd2) { const int dt = 2 * w + dd2; float an = 0.f;
#pragma unroll
            for (int sb = 0; sb < 4; ++sb) { const s16x4 kv = tr16(L + ML_KS + (16 * sb + 4 * g + (i16 >> 2)) * ML_LD + (16 * dt + 4 * (i16 & 3)) * 2); const f32x4 w4 = *(const LAS f32x4*)(tab + 16 * sb + 4 * g);
                an += (__uint_as_float((unsigned)(unsigned short)kv[0] << 16) * w4[0] + __uint_as_float((unsigned)(unsigned short)kv[1] << 16) * w4[1]) + (__uint_as_float((unsigned)(unsigned short)kv[2] << 16) * w4[2] + __uint_as_float((unsigned)(unsigned short)kv[3] << 16) * w4[3]); }
            an += __shfl_xor(an, 16); an += __shfl_xor(an, 32);
            if (g == 0) nvec[16 * dt + i16] = wprev * nvec[16 * dt + i16] + an; } }
        __syncthreads();
    }
#undef ML_PREFETCH
    float* oc = A_OUT + (samp ? OUT_MLC_S : OUT_MLC_P) + ((size_t)(seq * MLH + h) * MLV + vbase + 16 * (w & 3) + i16) * MLQK + 4 * g;
    if (vw && doval) {
#pragma unroll
    for (int dt = 0; dt < 16; ++dt) *(f32x4*)(oc + 16 * dt) = C[dt]; }
    if (doden) { if (tid < MLQK) A_OUT[(samp ? OUT_MLN_S : OUT_MLN_P) + (seq * MLH + h) * MLQK + tid] = nvec[tid]; if (tid == 0) A_OUT[(samp ? OUT_MLM_S : OUT_MLM_P) + seq * MLH + h] = m; }
    __syncthreads();
}

__device__ __forceinline__ void ml_post(Frame& F) {
    const int gw = F.vcu * NWAVES + F.wave, NGW = F.G * NWAVES;
    for (int it0 = gw; it0 < M * MLH; it0 += 4 * NGW) {
        f32x4 a[4], b[4]; float dn[4]; v4u ow[4];
#pragma unroll
        for (int k = 0; k < 4; ++k) { int it = it0 + k * NGW; it = it < M * MLH ? it : it0; const int row = it >> 2, h = it & 3;
            const float* np = A_WS(float, WS_NUM) + (size_t)row * 2048 + h * MLV + 8 * F.lane; a[k] = *(const f32x4*)np; b[k] = *(const f32x4*)(np + 4);
            dn[k] = A_WS(float, WS_DEN)[(size_t)row * MLH + h]; ow[k] = *(const v4u*)(A_WS(bf16, WS_MO) + (size_t)row * 2048 + h * MLV + 8 * F.lane); }
#pragma unroll
        for (int k = 0; k < 4; ++k) { const int it = it0 + k * NGW; if (it >= M * MLH) continue; const int row = it >> 2, h = it & 3;
            const float dinv = 1.0f / dn[k];
            float hv[8] = {a[k][0] * dinv, a[k][1] * dinv, a[k][2] * dinv, a[k][3] * dinv, b[k][0] * dinv, b[k][1] * dinv, b[k][2] * dinv, b[k][3] * dinv};
            float ss = 0.f;
#pragma unroll
            for (int e = 0; e < 8; ++e) ss += hv[e] * hv[e];
            ss = wave_sum(ss);
            const float rinv = rsqrtf(ss * (1.0f / MLV) + EPS);
            const float* gp = A_IN(17) + h * MLV + 8 * F.lane; const f32x4 g0 = *(const f32x4*)gp, g1 = *(const f32x4*)(gp + 4);
            const float ov[8] = {bf_lo(ow[k].x), bf_hi(ow[k].x), bf_lo(ow[k].y), bf_hi(ow[k].y), bf_lo(ow[k].z), bf_hi(ow[k].z), bf_lo(ow[k].w), bf_hi(ow[k].w)};
            const float gv[8] = {g0[0], g0[1], g0[2], g0[3], g1[0], g1[1], g1[2], g1[3]};
            float y[8];
#pragma unroll
            for (int e = 0; e < 8; ++e) y[e] = hv[e] * rinv * gv[e] / (1.0f + __expf(-ov[e]));
            v4u wv; wv.x = cvtpk(y[0], y[1]); wv.y = cvtpk(y[2], y[3]); wv.z = cvtpk(y[4], y[5]); wv.w = cvtpk(y[6], y[7]);
            *(v4u*)(A_WS(bf16, WS_MIX) + (size_t)row * LDX + 2048 + h * MLV + 8 * F.lane) = wv; } }
}
__device__ __forceinline__ void final_norm(Frame& F) {
    const int gw = F.vcu * NWAVES + F.wave, NGW = F.G * NWAVES;
    for (int row = gw; row < M; row += NGW) { const float rs = pg8::rs_of(A_SSQ(4), row); const v4u* xr = (const v4u*)(A_WS(bf16, WS_XB) + (size_t)row * D) + F.lane; f32x4* yr = (f32x4*)(A_XF + (size_t)row * D) + 2 * F.lane; const f32x4* gr = (const f32x4*)A_IN(26) + 2 * F.lane;
#pragma unroll
        for (int j = 0; j < 8; ++j) { const v4u v = xr[64 * j]; const f32x4 g0 = gr[128 * j], g1 = gr[128 * j + 1];
            yr[128 * j] = (f32x4){bf_lo(v.x), bf_hi(v.x), bf_lo(v.y), bf_hi(v.y)} * rs * g0; yr[128 * j + 1] = (f32x4){bf_lo(v.z), bf_hi(v.z), bf_lo(v.w), bf_hi(v.w)} * rs * g1; } }
}

__global__ void __launch_bounds__(NWAVES * 64, 2) hsm_fwd(Args args) {
    extern __shared__ __attribute__((aligned(16))) unsigned char lds[];
    Frame F;
    F.lds = (LAS unsigned char*)lds; F.MISC = (volatile LAS unsigned*)(F.lds + MISC_OFF);
    F.tid = threadIdx.x; F.lane = F.tid & 63; F.wave = __builtin_amdgcn_readfirstlane(F.tid >> 6);
    F.G = gridDim.x; { const int bx = blockIdx.x; F.vcu = (F.G % 8 == 0) ? (bx % 8) * (F.G / 8) + bx / 8 : bx; }
    unsigned char* ws = args.ws; F.a = &args;
    for (int u = F.tid; u < 64; u += NWAVES * 64) ((LAS unsigned*)(F.lds + MISC_OFF))[u] = 0u;
    __syncthreads();
    XcdBarrier bar; bar.bar = (unsigned*)(ws + CTL_BAR_BYTE); bar.x = 0; bar.st = nullptr;
    if (MK_N_LAUNCHES == 1) bar = xcd_barrier_post((unsigned*)(ws + CTL_BAR_BYTE), F.MISC + 8);
    const int lo = args.ph_lo, hi = args.ph_hi;
#ifndef PH_MASK
#define PH_MASK 0x7ff
#endif
#define IN(k) (((PH_MASK >> (k)) & 1) && lo <= (k) && (k) < hi)
#define SEAM(k) do { if (IN(k) && IN((k) + 1)) xcd_barrier(bar); } while (0)
    const int bx = (int)blockIdx.x;

    if (IN(0)) { p0_prologue(F); } SEAM(0);
    if (IN(1)) {
        { pg8::Gemm g{A_WS(bf16, WS_XB), A_WS(bf16, WS_W1GU), M, NGU, D, LDX}; pg8::SplitOrder S; S.init(M, NGU, D, F.G, bx, F.a->ws + WS_SLAB, (unsigned*)(F.a->ws + CTL_CNT_BYTE) + 0 * 512 * 32); pg8::EpiGateUp<false, false> E{F.a->ws, WS_HB, 0}; pg8::gemm_phase<pg8::EpiGateUp<false, false>, pg8::SplitOrder, true, true>(F.lds, g, S, E); }
    } SEAM(1);
    if (IN(2)) { pg8::Gemm g{A_WS(bf16, WS_HB), A_WS(bf16, WS_W1D), M, D, FFN, LDH}; pg8::SplitOrder S; S.init(M, D, FFN, F.G, bx, F.a->ws + WS_SLAB, (unsigned*)(F.a->ws + CTL_CNT_BYTE) + 1 * 512 * 32); pg8::EpiResid<false, true> E{nullptr, nullptr, F.a->ws, 0.5f, 1};
        pg8::gemm_phase<pg8::EpiResid<false, true>, pg8::SplitOrder, true, true>(F.lds, g, S, E); } SEAM(2);
    if (IN(3)) { gates_rows(F);
        pg8::Gemm g{A_WS(bf16, WS_XB), A_WS(bf16, WS_WIN), M, NIN, D, LDX}; pg8::SplitOrder S; S.init(M, NIN, D, F.G, bx, F.a->ws + WS_SLAB, (unsigned*)(F.a->ws + CTL_CNT_BYTE) + 2 * 512 * 32);
        pg8::EpiWin E{F.a->ws, A_OUT};
        pg8::gemm_phase<pg8::EpiWin, pg8::SplitOrder, true, true>(F.lds, g, S, E); } SEAM(3);
    if (IN(4)) {
        if (bx < 72) { const bool dn = bx >= 64; const int sh = dn ? bx - 64 : (bx & 7);
            mlstm_scan(F, sh >> 2, sh & 3, dn ? 0 : (bx >> 3), false, !dn, dn); }
        else { const int j = bx - 72, nb = F.G - 72;
            { pg8::Gemm g{A_WS(bf16, WS_PB), A_WS(bf16, WS_WPP), M, D, PLE, PLE}; pg8::SplitOrder S; S.init(M, D, PLE, nb, j, F.a->ws + WS_SLAB, (unsigned*)(F.a->ws + CTL_CNT_BYTE) + 3 * 512 * 32); pg8::EpiPlain E{A_WS(bf16, WS_PP), D}; pg8::gemm_phase<pg8::EpiPlain, pg8::SplitOrder, true, true>(F.lds, g, S, E); }
            __syncthreads();
            for (int su = j; su < DBATCH * MLH * 8; su += nb) mlstm_scan(F, su >> 5, (su >> 3) & 3, su & 7, true, true, (su & 7) == 0);
            const int nw = nb * NWAVES;
            const int n2 = 2 * DBATCH * MLH * 8 - 2 * nb > 0 ? DBATCH * MLH * 8 - nb : 0;
            const int jo = (j >= n2) ? (j - n2) * NWAVES + F.wave : -1, nwo = (nb - n2) * NWAVES;
            __syncthreads();
            if (F.wave < 4) { for (int u = j * NWAVES + F.wave; u < (M / 16) * SBH; u += nw) sb_unit(F, u, F.lds + F.wave * SB_VBYTES); p0_late_weights(F, j * NWAVES + F.wave, nw, jo, nwo); p0_ple_weights(F, j * NWAVES + F.wave, nw); }
            else { p0_late_weights(F, j * NWAVES + F.wave, nw, jo, nwo); p0_ple_weights(F, j * NWAVES + F.wave, nw); for (int u = j * NWAVES + F.wave; u < (M / 16) * SBH; u += nw) sb_unit(F, u, F.lds + F.wave * SB_VBYTES); } }
    } SEAM(4);
    if (IN(5)) { ml_post(F); } SEAM(5);
    if (IN(6)) { pg8::Gemm g{A_WS(bf16, WS_MIX), A_WS(bf16, WS_WOUT), M, D, D, LDX}; pg8::SplitOrder S; S.init(M, D, D, F.G, bx, F.a->ws + WS_SLAB, (unsigned*)(F.a->ws + CTL_CNT_BYTE) + 4 * 512 * 32); pg8::EpiResid<true, true> E{nullptr, nullptr, F.a->ws, 1.0f, 2};
        pg8::gemm_phase<pg8::EpiResid<true, true>, pg8::SplitOrder, true, true>(F.lds, g, S, E); } SEAM(6);
    if (IN(7)) { pg8::Gemm g{A_WS(bf16, WS_XB8), A_WS(bf16, WS_W2GU), M, NGU, D / 2, D / 2}; pg8::SplitOrder S; S.init(M, NGU, D / 2, F.G, bx, F.a->ws + WS_SLAB, (unsigned*)(F.a->ws + CTL_CNT_BYTE) + 5 * 512 * 32); pg8::EpiGateUp<true, true> E{F.a->ws, WS_HB, 2};
        pg8::gemm_phase<pg8::EpiGateUp<true, true>, pg8::SplitOrder, true, true, true>(F.lds, g, S, E); } SEAM(7);
    if (IN(8)) { pg8::Gemm g{A_WS(bf16, WS_HB), A_WS(bf16, WS_W2D), M, D, FFN / 2, FFN / 2}; pg8::SplitOrder S; S.init(M, D, FFN / 2, F.G, bx, F.a->ws + WS_SLAB, (unsigned*)(F.a->ws + CTL_CNT_BYTE) + 6 * 512 * 32); pg8::EpiResid<true, true> E{nullptr, nullptr, F.a->ws, 0.5f / 64.f, 3};
        pg8::gemm_phase<pg8::EpiResid<true, true>, pg8::SplitOrder, true, true, true>(F.lds, g, S, E); } SEAM(8);
    if (IN(9)) { pg8::Gemm g{A_WS(bf16, WS_XB8), A_WS(bf16, WS_WPG), M, D, D / 2, D / 2}; pg8::SplitOrder S; S.init(M, D, D / 2, F.G, bx, F.a->ws + WS_SLAB, (unsigned*)(F.a->ws + CTL_CNT_BYTE) + 7 * 512 * 32); pg8::EpiPle E{F.a->ws, 1.0f / 64.f};
        pg8::gemm_phase<pg8::EpiPle, pg8::SplitOrder, true, true, true>(F.lds, g, S, E); } SEAM(9);
    if (IN(10)) { final_norm(F); }
#undef IN
#undef SEAM
}

extern "C" void kernel_launch(void* const* d_in, const int* in_sizes, int n_in, void* d_out, int out_size, void* d_ws, size_t ws_size, hipStream_t stream) {
    static int grid = 0;
    if (grid == 0) {
        if (n_in != 27 || out_size != (int)OUT_END || ws_size < WS_END) { fprintf(stderr, "kernel_launch: unexpected shapes (n_in %d, out %d, ws %zu; need ws >= %zu)\n", n_in, out_size, ws_size, (size_t)WS_END); grid = -1; return; }
        int dev = 0, cus = 0, per_cu = 0;
        if (hipGetDevice(&dev) != hipSuccess || hipDeviceGetAttribute(&cus, hipDeviceAttributeMultiprocessorCount, dev) != hipSuccess) { grid = -1; return; }
        if (hipFuncSetAttribute((const void*)hsm_fwd, hipFuncAttributeMaxDynamicSharedMemorySize, LDS_BYTES) != hipSuccess) { fprintf(stderr, "kernel_launch: hipFuncSetAttribute failed\n"); grid = -1; return; }
        if (hipOccupancyMaxActiveBlocksPerMultiprocessor(&per_cu, (const void*)hsm_fwd, NWAVES * 64, LDS_BYTES) != hipSuccess || per_cu < 1) fprintf(stderr, "kernel_launch: occupancy query says %d\n", per_cu);
        (void)hipGetLastError();
        grid = cus;
    }
    if (grid < 0) return;
    if (hipMemsetAsync((char*)d_ws + WS_CTL, 0, CTL_ZERO_BYTES, stream) != hipSuccess) return;
    Args a{};
    for (int i = 0; i < 27; ++i) a.in[i] = (const float*)d_in[i];
    a.out = (float*)d_out; a.ws = (unsigned char*)d_ws;
#if MK_N_LAUNCHES == 1
    a.ph_lo = 0; a.ph_hi = N_PHASES;
    hipLaunchKernelGGL(hsm_fwd, dim3(grid), dim3(NWAVES * 64), LDS_BYTES, stream, a);
#else
    for (int p = 0; p < N_PHASES; ++p) { a.ph_lo = p; a.ph_hi = p + 1; hipLaunchKernelGGL(hsm_fwd, dim3(grid), dim3(NWAVES * 64), LDS_BYTES, stream, a); }
#endif
}
```

```cpp
#include <hip/hip_runtime.h>
#include <cstdio>
#include <cstdint>

constexpr int NWAVES = 8;
constexpr int D = 4096, MP = 8192, MS = 256, M = MP + MS, FFN = 11008, NGU = 2 * FFN, NIN = 12288, NINF = 12296;
constexpr int SBW = 2048, SBH = 16, SBD = 128, MLH = 4, MLQK = 256, MLV = 512, PLE = 256, SEQ = 4096, PAST = 4096, DSEQ = 32, DBATCH = 8, CHUNK = 64;
constexpr float EPS = 1e-6f;
constexpr int LDX = D, LDH = FFN;
#ifndef MK_N_LAUNCHES
#define MK_N_LAUNCHES 1
#endif
constexpr int N_PHASES = 11;
constexpr size_t OUT_Y = 0, OUT_SBK_P = (size_t)M * D, OUT_SBV_P = OUT_SBK_P + (size_t)MP * SBW, OUT_MLC_P = OUT_SBV_P + (size_t)MP * SBW, OUT_MLN_P = OUT_MLC_P + (size_t)2 * MLH * MLV * MLQK,
    OUT_MLM_P = OUT_MLN_P + 2 * MLH * MLQK, OUT_SBK_S = OUT_MLM_P + 2 * MLH, OUT_SBV_S = OUT_SBK_S + (size_t)MS * SBW, OUT_MLC_S = OUT_SBV_S + (size_t)MS * SBW,
    OUT_MLN_S = OUT_MLC_S + (size_t)DBATCH * MLH * MLV * MLQK, OUT_MLM_S = OUT_MLN_S + DBATCH * MLH * MLQK, OUT_END = OUT_MLM_S + DBATCH * MLH;
static_assert(OUT_END == 74459176, "output size");
constexpr size_t MiB = 1u << 20;
constexpr size_t al(size_t x) { return (x + MiB - 1) / MiB * MiB; }
constexpr size_t WS_CTL = 0, CTL_ZERO_BYTES = 2 * MiB;
constexpr size_t CTL_BAR_BYTE = 16384;
constexpr size_t CTL_SSQ_BYTE = 65536;
constexpr size_t WS_W1GU = 2 * MiB, WS_W1D = WS_W1GU + al((size_t)NGU * LDX * 2), WS_WIN = WS_W1D + al((size_t)D * LDH * 2), WS_WOUT = WS_WIN + al((size_t)NIN * LDX * 2),
    WS_W2GU = WS_WOUT + al((size_t)D * LDX * 2), WS_W2D = WS_W2GU + al((size_t)NGU * LDX * 2), WS_WPG = WS_W2D + al((size_t)D * LDH * 2), WS_WPP = WS_WPG + al((size_t)D * LDX * 2),
    WS_WIF = WS_WPP + al((size_t)D * PLE * 2), WS_XB = WS_WIF + al((size_t)8 * D * 4), WS_HB = WS_XB + al((size_t)M * LDX * 2), WS_QB = WS_HB + al((size_t)M * LDH * 2),
    WS_KB = WS_QB + al((size_t)M * SBW * 2), WS_VB = WS_KB + al((size_t)M * SBW * 2), WS_MQ = WS_VB + al((size_t)M * SBW * 2), WS_MK = WS_MQ + al((size_t)M * 1024 * 2),
    WS_MV = WS_MK + al((size_t)M * 1024 * 2), WS_MO = WS_MV + al((size_t)M * 2048 * 2), WS_GATES = WS_MO + al((size_t)M * 2048 * 2), WS_MIX = WS_GATES + al((size_t)M * 8 * 4),
    WS_PP = WS_MIX + al((size_t)M * LDX * 2), WS_PB = WS_PP + al((size_t)M * D * 2), WS_NUM = WS_PB + al((size_t)M * PLE * 2), WS_DEN = WS_NUM + al((size_t)M * 2048 * 4),
    WS_MLS = WS_DEN + al((size_t)M * 4 * 4), WS_XB8 = WS_MLS + al((size_t)256 * 21504 * 4)  , WS_SLAB = WS_XB8 + al((size_t)M * D)  , WS_END = WS_SLAB + (size_t)256 * 262144;
constexpr size_t CTL_CNT_BYTE = 1 * MiB;
static_assert(CTL_SSQ_BYTE + 6 * (size_t)M * 8 <= CTL_CNT_BYTE && CTL_CNT_BYTE + 8 * 512 * 128 <= CTL_ZERO_BYTES, "ctl");
constexpr int LDS_BYTES = 163840;
constexpr int MISC_OFF = 163840 - 256;

namespace pg8 {
#define PG8_LAS __attribute__((address_space(3)))
typedef unsigned short bf16_t;
typedef short bf16x8 __attribute__((ext_vector_type(8)));
typedef float f32x4 __attribute__((ext_vector_type(4)));
typedef unsigned u32x4 __attribute__((ext_vector_type(4)));
typedef int v8i __attribute__((ext_vector_type(8)));
constexpr int BM = 256, BK = 64, HALF = 128, HTB = HALF * BK * 2  , STAGE_BYTES = 8 * HTB, NXCD = 8, WGM = 8;

__host__ __device__ __forceinline__ int lds_byte(int r, int c) { const int st = (r >> 4) * 2 + (c >> 5), rr = r & 15, cc = c & 31, ob = rr * 64 + cc * 2; return st * 1024 + (ob ^ (((ob >> 9) & 1) << 5)); }
__host__ __device__ __forceinline__ void stage_rc(int b, int& R, int& C) { const int st = b / 1024, sb = b % 1024, swz = sb ^ (((sb >> 9) & 1) << 5); R = (st >> 1) * 16 + swz / 64; C = (st & 1) * 32 + (swz % 64) / 2; }
__host__ __device__ __forceinline__ int perm32(int rho) { const int n = rho >> 4, i = rho & 15; return 8 * (i >> 2) + 4 * n + (i & 3); }

struct Unit { int pm, pn, k0, nk, split, S, s, tile, xw, rx; };
constexpr int SLAB_BYTES = 256 * 256 * 4;
struct Gemm { const bf16_t* A; const bf16_t* Bt; int M, N, K, ld; };

struct StaticOrder {
    int nM, nN, nwg, G, c;
    __host__ __device__ void init(int M, int N, int G_, int c_) { nM = M / BM; nN = N / BM; nwg = nM * nN; G = G_; c = c_; }
    __host__ __device__ bool next(int i, Unit& u) const {
        const long L = (long)i * G + c; if (L >= nwg) return false;
        int wgid = (int)L; { const int q = nwg / NXCD, r = nwg % NXCD, xcd = wgid % NXCD, off = wgid / NXCD; wgid = (xcd < r ? xcd * (q + 1) : r * (q + 1) + (xcd - r) * q) + off; }
        const int nig = WGM * nN, gid = wgid / nig, fm = gid * WGM, gsz = (nM - fm) < WGM ? (nM - fm) : WGM;
        u.pm = fm + ((wgid % nig) % gsz); u.pn = (wgid % nig) / gsz; return true;
    }
    __device__ __forceinline__ void a_ready(const Unit&) const {}
    __device__ __forceinline__ void done(const Unit&) const {}
};
typedef float f32x2_t __attribute__((ext_vector_type(2)));
typedef __bf16 bf16x2_t __attribute__((ext_vector_type(2)));
typedef unsigned u32x2 __attribute__((ext_vector_type(2)));
__device__ __forceinline__ unsigned cvtpk(float lo, float hi) { f32x2_t v = {lo, hi}; bf16x2_t b = __builtin_convertvector(v, bf16x2_t); return __builtin_bit_cast(unsigned, b); }
template <class T> __device__ __forceinline__ T* opq(T* p) { const unsigned long long v = (unsigned long long)p; unsigned lo = __builtin_amdgcn_readfirstlane((unsigned)v), hi = __builtin_amdgcn_readfirstlane((unsigned)(v >> 32));
    asm volatile("" : "+s"(lo), "+s"(hi)); return (T*)(((unsigned long long)hi << 32) | lo); }
__device__ __forceinline__ float opqf(float x) { unsigned v = __builtin_amdgcn_readfirstlane(__float_as_uint(x)); asm volatile("" : "+s"(v)); return __uint_as_float(v); }
constexpr int DM = 4096, DFF = 11008, MPROMPT = 8192;
constexpr float SSQ_SCALE = 16777216.0f;
__device__ __forceinline__ float rs_of(const unsigned long long* ssq, int row) { return rsqrtf((float)ssq[row] * (1.0f / (16777216.0f * 4096.0f)) + 1e-6f); }
__device__ __forceinline__ unsigned pack4_fp8(float a, float b, float c, float d) { int w = __builtin_amdgcn_cvt_pk_fp8_f32(a, b, 0, false); w = __builtin_amdgcn_cvt_pk_fp8_f32(c, d, w, true); return (unsigned)w; }
__device__ __forceinline__ unsigned long long ssq_fix(float s) { return (unsigned long long)(s * SSQ_SCALE + 0.5f); }


struct SplitOrder {
    int nM, nN, nwg, G, c, ntk, Rf, r, split_ok; unsigned char* slab; unsigned* cnt;
    __device__ __forceinline__ void init(int M, int N, int K, int G_, int c_, unsigned char* slab_, unsigned* cnt_) { nM = M / BM; nN = N / BM; nwg = nM * nN; G = __builtin_amdgcn_readfirstlane(G_); c = __builtin_amdgcn_readfirstlane(c_); ntk = K / BK;
        Rf = __builtin_amdgcn_readfirstlane(nwg / G); r = nwg - Rf * G; slab = slab_; cnt = cnt_; split_ok = (G % 8 == 0) && (G >= 64) && (ntk >= 8) && (ntk % 2 == 0); }
    __device__ __forceinline__ void map(int L, Unit& u) const {
        int wgid = L; { const int q = nwg / NXCD, r8 = nwg % NXCD, xcd = wgid % NXCD, off = wgid / NXCD; wgid = (xcd < r8 ? xcd * (q + 1) : r8 * (q + 1) + (xcd - r8) * q) + off; }
        const int nig = WGM * nN, gid = wgid / nig, fm = gid * WGM, gsz = (nM - fm) < WGM ? (nM - fm) : WGM;
        u.pm = __builtin_amdgcn_readfirstlane(fm + ((wgid % nig) % gsz)); u.pn = __builtin_amdgcn_readfirstlane((wgid % nig) / gsz); }
    __device__ __forceinline__ bool next(int i, Unit& u) const {
        u.k0 = 0; u.nk = ntk; u.split = 0; u.S = 1; u.s = 0; u.tile = 0; u.xw = 0; u.rx = 1;
        if (i < Rf) { map(i * G + c, u); return true; }
        if (i > Rf || r == 0) return false;
        if (!split_ok) { if (c >= r) return false; map(Rf * G + c, u); return true; }
        const int x = c & 7, w = c >> 3, W = G >> 3, rx = (x < r) ? (r - x + 7) / 8 : 0;
        if (rx == 0) return false;
        const int s = __builtin_amdgcn_readfirstlane(w / rx), tp = w - s * rx; int S = __builtin_amdgcn_readfirstlane((W - tp + rx - 1) / rx); const int np = ntk / 2; if (S > np / 2) S = np / 2;
        if (s >= S) return false;
        const int j = x + 8 * tp; map(Rf * G + j, u);
        const int p0 = __builtin_amdgcn_readfirstlane((s * np) / S), p1 = __builtin_amdgcn_readfirstlane(((s + 1) * np) / S);
        u.k0 = 2 * p0; u.nk = 2 * (p1 - p0); u.split = (S > 1) ? 1 : 0; u.S = S; u.s = s; u.tile = j; u.xw = x + 8 * tp; u.rx = rx; return true; }
    __device__ __forceinline__ void a_ready(const Unit&) const {}
    __device__ __forceinline__ void done(const Unit&) const {}
};

template <bool W8, bool H8> struct EpiGateUp {
    static constexpr bool PERM = false, AFTER_DRAIN = false;
    unsigned char* ws; size_t h_off; int ssq_k;
    __device__ __forceinline__ void operator()(const f32x4 (&acc)[2][2][4][2], const Unit& u, int wr, int wc, int fr, int fq, unsigned mask) const {
        const int row0 = u.pm * BM + wr * 64 + fr, col0 = u.pn * 128 + wc * 16 + 4 * fq; unsigned char* const wsp = opq(this->ws); bf16_t* const H = (bf16_t*)(wsp + h_off); const unsigned long long* const ssq = (const unsigned long long*)(wsp + CTL_SSQ_BYTE) + (size_t)ssq_k * 8448;
#pragma unroll
        for (int ai = 0; ai < 2; ++ai)
#pragma unroll
            for (int m = 0; m < 4; ++m) { if (!((mask >> ((ai * 4 + m) * 2)) & 3u)) continue; const int row = row0 + ai * HALF + m * 16; const float rs = rs_of(ssq, row) * (W8 ? 0.015625f : 1.0f); bf16_t* rowp = H + (size_t)row * LDH + col0;
#pragma unroll
                for (int bj = 0; bj < 2; ++bj) { if (!((mask >> ((ai * 4 + m) * 2 + bj)) & 1u)) continue; const f32x4 g = acc[ai][bj][m][0] * rs, up = acc[ai][bj][m][1] * rs; f32x4 h;
#pragma unroll
                    for (int e = 0; e < 4; ++e) h[e] = g[e] * __builtin_amdgcn_rcpf(1.0f + __expf(-g[e])) * up[e];
                    if constexpr (H8) *(unsigned*)((unsigned char*)H + (size_t)row * DFF + col0 + bj * 64) = pack4_fp8(h[0], h[1], h[2], h[3]);
                    else { u32x2 w; w.x = cvtpk(h[0], h[1]); w.y = cvtpk(h[2], h[3]); *(u32x2*)(rowp + bj * 64) = w; } } }
    }
};
template <bool OUT8, bool RESB> struct EpiResid {
    static constexpr bool PERM = true, AFTER_DRAIN = false;
    const float* res_p; const float* res_s; unsigned char* ws; float alpha; int ssq_k;
    __device__ __forceinline__ void operator()(const f32x4 (&acc)[2][2][4][2], const Unit& u, int wr, int wc, int fr, int fq, unsigned mask) const {
        const int row0 = u.pm * BM + wr * 64 + fr, col0 = u.pn * BM + wc * 32 + 8 * fq;
        const float* src = RESB ? nullptr : opq((u.pm < 32) ? res_p : (res_s - (size_t)MPROMPT * DM)); unsigned char* const wsp = opq(this->ws); bf16_t* const XB = (bf16_t*)(wsp + WS_XB); unsigned long long* const ssq_out = (unsigned long long*)(wsp + CTL_SSQ_BYTE) + (size_t)ssq_k * 8448; const float alpha = opqf(this->alpha);
#pragma unroll
        for (int ai = 0; ai < 2; ++ai)
#pragma unroll
            for (int m = 0; m < 4; ++m) { if (!((mask >> ((ai * 4 + m) * 2)) & 3u)) continue; const int row = row0 + ai * HALF + m * 16; const size_t off = (size_t)row * DM + col0; float ss = 0.f;
#pragma unroll
                for (int bj = 0; bj < 2; ++bj) { if (!((mask >> ((ai * 4 + m) * 2 + bj)) & 1u)) continue; bf16_t* const xb = XB + (size_t)row * LDX + col0 + bj * HALF; f32x4 r0, r1;
                    if constexpr (RESB) { const u32x4 rw = *(const u32x4*)xb; r0[0] = __uint_as_float(rw.x << 16); r0[1] = __uint_as_float(rw.x & 0xffff0000u); r0[2] = __uint_as_float(rw.y << 16); r0[3] = __uint_as_float(rw.y & 0xffff0000u);
                        r1[0] = __uint_as_float(rw.z << 16); r1[1] = __uint_as_float(rw.z & 0xffff0000u); r1[2] = __uint_as_float(rw.w << 16); r1[3] = __uint_as_float(rw.w & 0xffff0000u); }
                    else { r0 = *(const f32x4*)(src + off + bj * HALF); r1 = *(const f32x4*)(src + off + bj * HALF + 4); }
                    const f32x4 o0 = r0 + acc[ai][bj][m][0] * alpha, o1 = r1 + acc[ai][bj][m][1] * alpha;
                    { u32x4 w; w.x = cvtpk(o0[0], o0[1]); w.y = cvtpk(o0[2], o0[3]); w.z = cvtpk(o1[0], o1[1]); w.w = cvtpk(o1[2], o1[3]); *(u32x4*)xb = w; }
                    if constexpr (OUT8) { u32x2 q; q.x = pack4_fp8(o0[0], o0[1], o0[2], o0[3]); q.y = pack4_fp8(o1[0], o1[1], o1[2], o1[3]); *(u32x2*)(wsp + WS_XB8 + (size_t)row * DM + col0 + bj * HALF) = q; }
                    ss += ((o0[0] * o0[0] + o0[1] * o0[1]) + (o0[2] * o0[2] + o0[3] * o0[3])) + ((o1[0] * o1[0] + o1[1] * o1[1]) + (o1[2] * o1[2] + o1[3] * o1[3])); }
                ss += __shfl_xor(ss, 16); ss += __shfl_xor(ss, 32);
                if (fq == 0) atomicAdd(ssq_out + row, ssq_fix(ss));
                if (m == 3) asm volatile("" ::: "memory"); }
    }
};
struct EpiPle {
    static constexpr bool PERM = true, AFTER_DRAIN = false;
    unsigned char* ws; float zscale;
    __device__ __forceinline__ void operator()(const f32x4 (&acc)[2][2][4][2], const Unit& u, int wr, int wc, int fr, int fq, unsigned mask) const {
        const int row0 = u.pm * BM + wr * 64 + fr, col0 = u.pn * BM + wc * 32 + 8 * fq;
        unsigned char* const wsp = opq(this->ws); const float zscale = opqf(this->zscale); const bf16_t* const PP = (const bf16_t*)(wsp + WS_PP); bf16_t* const XB = (bf16_t*)(wsp + WS_XB); const unsigned long long* const ssq = (const unsigned long long*)(wsp + CTL_SSQ_BYTE) + (size_t)3 * 8448; unsigned long long* const ssq_out = (unsigned long long*)(wsp + CTL_SSQ_BYTE) + (size_t)4 * 8448;
#pragma unroll
        for (int ai = 0; ai < 2; ++ai)
#pragma unroll
            for (int m = 0; m < 4; ++m) { if (!((mask >> ((ai * 4 + m) * 2)) & 3u)) continue; const int row = row0 + ai * HALF + m * 16; const size_t off = (size_t)row * DM + col0; const float rs = rs_of(ssq, row) * zscale; float ss = 0.f;
#pragma unroll
                for (int bj = 0; bj < 2; ++bj) { if (!((mask >> ((ai * 4 + m) * 2 + bj)) & 1u)) continue; bf16_t* const xb = XB + (size_t)row * LDX + col0 + bj * HALF;
                    const u32x4 xw = *(const u32x4*)xb; const u32x4 pw = *(const u32x4*)(PP + off + bj * HALF);
                    const unsigned xs[4] = {xw.x, xw.y, xw.z, xw.w}, ps[4] = {pw.x, pw.y, pw.z, pw.w}; unsigned ow[4];
#pragma unroll
                    for (int n = 0; n < 2; ++n) { const f32x4 z = acc[ai][bj][m][n] * rs;
#pragma unroll
                        for (int hh = 0; hh < 2; ++hh) { const unsigned xv = xs[2 * n + hh], pv = ps[2 * n + hh];
                            const float oa = __uint_as_float(xv << 16) + __builtin_amdgcn_rcpf(1.0f + __expf(-z[2 * hh])) * __uint_as_float(pv << 16);
                            const float ob = __uint_as_float(xv & 0xffff0000u) + __builtin_amdgcn_rcpf(1.0f + __expf(-z[2 * hh + 1])) * __uint_as_float(pv & 0xffff0000u);
                            ow[2 * n + hh] = cvtpk(oa, ob); ss += oa * oa + ob * ob; } }
                    { u32x4 w; w.x = ow[0]; w.y = ow[1]; w.z = ow[2]; w.w = ow[3]; *(u32x4*)xb = w; } }
                ss += __shfl_xor(ss, 16); ss += __shfl_xor(ss, 32);
                if (fq == 0) atomicAdd(ssq_out + row, ssq_fix(ss));
                if (m == 3) asm volatile("" ::: "memory"); }
    }
};
struct EpiPlain {
    static constexpr bool PERM = false, AFTER_DRAIN = false;
    bf16_t* O; int ldc;
    __device__ __forceinline__ void operator()(const f32x4 (&acc)[2][2][4][2], const Unit& u, int wr, int wc, int fr, int fq, unsigned mask) const {
        const int row0 = u.pm * BM + wr * 64 + fr, col0 = u.pn * BM + wc * 32 + 4 * fq;
#pragma unroll
        for (int ai = 0; ai < 2; ++ai)
#pragma unroll
            for (int m = 0; m < 4; ++m) { if (!((mask >> ((ai * 4 + m) * 2)) & 3u)) continue; bf16_t* rowp = opq(O) + (size_t)(row0 + ai * HALF + m * 16) * ldc + col0;
#pragma unroll
                for (int bj = 0; bj < 2; ++bj)
#pragma unroll
                    for (int n = 0; n < 2; ++n) { if (!((mask >> ((ai * 4 + m) * 2 + bj)) & 1u)) continue; const f32x4 v = acc[ai][bj][m][n]; u32x2 w; w.x = cvtpk(v[0], v[1]); w.y = cvtpk(v[2], v[3]); *(u32x2*)(rowp + bj * HALF + n * 16) = w; } }
    }
};
struct EpiWin {
    static constexpr bool PERM = true, AFTER_DRAIN = false;
    unsigned char* ws; float* out;
    __device__ __forceinline__ void operator()(const f32x4 (&acc)[2][2][4][2], const Unit& u, int wr, int wc, int fr, int fq, unsigned mask) const {
        const int row0 = u.pm * BM + wr * 64 + fr; const int pn = u.pn;
        bf16_t* dst; int ld, cbase; float sc = 1.f; float* fdst = nullptr;
        unsigned char* const wsp = opq(this->ws); float* const outp = opq(this->out); size_t doff;
        if (pn < 8) { doff = WS_QB; ld = 2048; cbase = pn * 256; sc = 0.08838834764831845f; }
        else if (pn < 16) { doff = WS_KB; ld = 2048; cbase = (pn - 8) * 256; fdst = (u.pm < 32) ? outp + OUT_SBK_P : (outp + OUT_SBK_S - (size_t)MPROMPT * 2048); }
        else if (pn < 24) { doff = WS_VB; ld = 2048; cbase = (pn - 16) * 256; fdst = (u.pm < 32) ? outp + OUT_SBV_P : (outp + OUT_SBV_S - (size_t)MPROMPT * 2048); }
        else if (pn < 28) { doff = WS_MQ; ld = 1024; cbase = (pn - 24) * 256; sc = 0.0625f; }
        else if (pn < 32) { doff = WS_MK; ld = 1024; cbase = (pn - 28) * 256; }
        else if (pn < 40) { doff = WS_MV; ld = 2048; cbase = (pn - 32) * 256; }
        else { doff = WS_MO; ld = 2048; cbase = (pn - 40) * 256; }
        dst = (bf16_t*)(wsp + doff);
        const int col0 = cbase + wc * 32 + 8 * fq; const unsigned long long* const ssq = (const unsigned long long*)(wsp + CTL_SSQ_BYTE) + (size_t)1 * 8448;
#pragma unroll
        for (int ai = 0; ai < 2; ++ai)
#pragma unroll
            for (int m = 0; m < 4; ++m) { if (!((mask >> ((ai * 4 + m) * 2)) & 3u)) continue; const int row = row0 + ai * HALF + m * 16; const float rs = rs_of(ssq, row) * sc; bf16_t* rowp = dst + (size_t)row * ld + col0;
#pragma unroll
                for (int bj = 0; bj < 2; ++bj) { if (!((mask >> ((ai * 4 + m) * 2 + bj)) & 1u)) continue; const f32x4 v0 = acc[ai][bj][m][0] * rs, v1 = acc[ai][bj][m][1] * rs;
                    u32x4 w; w.x = cvtpk(v0[0], v0[1]); w.y = cvtpk(v0[2], v0[3]); w.z = cvtpk(v1[0], v1[1]); w.w = cvtpk(v1[2], v1[3]);
                    *(u32x4*)(rowp + bj * HALF) = w;
                    if (fdst) { float* fp = fdst + (size_t)row * 2048 + col0 + bj * HALF; __builtin_nontemporal_store(v0, (f32x4*)fp); __builtin_nontemporal_store(v1, (f32x4*)(fp + 4)); } } }
    }
};

template <class Epi, class Sched, bool ALIGN_EPI = false, bool SP2 = false, bool F8 = false>
__device__ __forceinline__ void gemm_phase(PG8_LAS unsigned char* lds, const Gemm g, const Sched& S, const Epi& E) {
    const int tid = threadIdx.x, wid = __builtin_amdgcn_readfirstlane(tid >> 6), lane = tid & 63, wr = wid >> 2, wc = wid & 3, fr = lane & 15, fq = lane >> 4;
    const int K = g.K;
    unsigned voffA[2], voffB[2];
#pragma unroll
    for (int i = 0; i < 2; ++i) { int R, C; stage_rc(tid * 16 + i * 8192, R, C); const int Rb = Epi::PERM ? ((R & ~31) + perm32(R & 31)) : R;
        voffA[i] = (unsigned)(R * g.ld + C) * 2u; voffB[i] = (unsigned)(Rb * g.ld + C) * 2u; }
    const size_t kstep = (size_t)(BK * 2);
    const size_t hstep = (size_t)HALF * g.ld * 2;
    const size_t tstep = 2 * hstep;
    const unsigned ldsw = (unsigned)wid * 1024u;
    const int aoff = lds_byte(wr * 64 + fr, fq * 8), boff = lds_byte(wc * 32 + fr, fq * 8);
    const int aoff8a = lds_byte(wr * 64 + fr, fq * 16), aoff8b = lds_byte(wr * 64 + fr, fq * 16 + 8), boff8a = lds_byte(wc * 32 + fr, fq * 16), boff8b = lds_byte(wc * 32 + fr, fq * 16 + 8);
#define PG8_SA(b, h) (((b) * 2 + (h)) * HTB)
#define PG8_SB(b, h) ((4 + (b) * 2 + (h)) * HTB)
#define PG8_STAGE(bufoff, gbase, voff) do { _Pragma("unroll") for (int _i = 0; _i < 2; ++_i) \
        __builtin_amdgcn_global_load_lds((const unsigned*)((const char*)(gbase) + (voff)[_i]), (PG8_LAS unsigned*)(lds + (bufoff) + ldsw + _i * 8192), 16, 0, 0); } while (0)
#define PG8_LDA(dst, b, h) do { if constexpr (F8) { _Pragma("unroll") for (int m = 0; m < 4; ++m) { const u32x4 lo_ = *(const PG8_LAS u32x4*)(lds + PG8_SA(b, h) + aoff8a + m * 2048), hi_ = *(const PG8_LAS u32x4*)(lds + PG8_SA(b, h) + aoff8b + m * 2048); \
            dst##8[m] = (v8i){(int)lo_.x, (int)lo_.y, (int)lo_.z, (int)lo_.w, (int)hi_.x, (int)hi_.y, (int)hi_.z, (int)hi_.w}; } } \
        else { _Pragma("unroll") for (int m = 0; m < 4; ++m) _Pragma("unroll") for (int k = 0; k < 2; ++k) dst[m][k] = *(const PG8_LAS bf16x8*)(lds + PG8_SA(b, h) + aoff + m * 2048 + k * 1024); } } while (0)
#define PG8_LDB(dst, b, h) do { if constexpr (F8) { _Pragma("unroll") for (int n = 0; n < 2; ++n) { const u32x4 lo_ = *(const PG8_LAS u32x4*)(lds + PG8_SB(b, h) + boff8a + n * 2048), hi_ = *(const PG8_LAS u32x4*)(lds + PG8_SB(b, h) + boff8b + n * 2048); \
            dst##8[n] = (v8i){(int)lo_.x, (int)lo_.y, (int)lo_.z, (int)lo_.w, (int)hi_.x, (int)hi_.y, (int)hi_.z, (int)hi_.w}; } } \
        else { _Pragma("unroll") for (int n = 0; n < 2; ++n) _Pragma("unroll") for (int k = 0; k < 2; ++k) dst[n][k] = *(const PG8_LAS bf16x8*)(lds + PG8_SB(b, h) + boff + n * 2048 + k * 1024); } } while (0)
#define PG8_MMA(ai, bj, At, Bt) do { __builtin_amdgcn_s_setprio(1); \
        if constexpr (F8) { _Pragma("unroll") for (int m = 0; m < 4; ++m) _Pragma("unroll") for (int n = 0; n < 2; ++n) \
            asm volatile("v_mfma_f32_16x16x128_f8f6f4 %0, %1, %2, %0" : "+v"(acc[ai][bj][m][n]) : "v"(Bt##8[n]), "v"(At##8[m])); } \
        else { _Pragma("unroll") for (int m = 0; m < 4; ++m) _Pragma("unroll") for (int n = 0; n < 2; ++n) _Pragma("unroll") for (int k = 0; k < 2; ++k) \
            acc[ai][bj][m][n] = __builtin_amdgcn_mfma_f32_16x16x32_bf16(Bt[n][k], At[m][k], acc[ai][bj][m][n], 0, 0, 0); } __builtin_amdgcn_s_setprio(0); } while (0)
#define PG8_WAIT_V(n) asm volatile("s_waitcnt vmcnt(" #n ")" ::: "memory")
#define PG8_WAIT_L(n) asm volatile("s_waitcnt lgkmcnt(" #n ")" ::: "memory")
#define PG8_BAR __builtin_amdgcn_s_barrier()
#define PG8_SCHED __builtin_amdgcn_sched_barrier(0)
    Unit cur, nxt; int ui = 0;
    if (!S.next(0, cur)) return;
    f32x4 acc[2][2][4][2];
#pragma unroll
    for (int a = 0; a < 2; ++a)
#pragma unroll
        for (int b = 0; b < 2; ++b)
#pragma unroll
            for (int m = 0; m < 4; ++m)
#pragma unroll
                for (int n = 0; n < 2; ++n) acc[a][b][m][n] = (f32x4){0.f, 0.f, 0.f, 0.f};
    bf16x8 At[4][2], B0[2][2], B1[2][2]; v8i At8[4], B08[2], B18[2];
    int sc127 = 127; asm volatile("" : "+v"(sc127));
    const char* cA = (const char*)g.A + (size_t)cur.pm * tstep + (size_t)cur.k0 * kstep; const char* cB = (const char*)g.Bt + (size_t)cur.pn * tstep + (size_t)cur.k0 * kstep;
    S.a_ready(cur);
    if constexpr (SP2) {
        PG8_STAGE(PG8_SB(0, 0), cB, voffB); PG8_STAGE(PG8_SB(0, 1), cB + hstep, voffB); PG8_STAGE(PG8_SA(0, 0), cA, voffA); PG8_STAGE(PG8_SA(0, 1), cA + hstep, voffA);
        if (wr == 1) PG8_BAR;
        PG8_WAIT_V(2); PG8_BAR;
        PG8_STAGE(PG8_SB(1, 0), cB + kstep, voffB); PG8_STAGE(PG8_SA(1, 0), cA + kstep, voffA); PG8_STAGE(PG8_SB(1, 1), cB + hstep + kstep, voffB);
        PG8_WAIT_V(6); PG8_BAR;
    } else {
        PG8_STAGE(PG8_SB(0, 0), cB, voffB); PG8_STAGE(PG8_SA(0, 0), cA, voffA); PG8_STAGE(PG8_SB(0, 1), cB + hstep, voffB); PG8_STAGE(PG8_SA(0, 1), cA + hstep, voffA);
        if (wr == 1) PG8_BAR;
        PG8_WAIT_V(4); PG8_BAR;
        PG8_STAGE(PG8_SB(1, 0), cB + kstep, voffB); PG8_STAGE(PG8_SA(1, 0), cA + kstep, voffA); PG8_STAGE(PG8_SB(1, 1), cB + hstep + kstep, voffB);
        PG8_WAIT_V(6); PG8_BAR;
    }
    for (;;) {
        const bool has_next = S.next(ui + 1, nxt);
        const char* nA = has_next ? (const char*)g.A + (size_t)nxt.pm * tstep + (size_t)nxt.k0 * kstep : cA; const char* nB = has_next ? (const char*)g.Bt + (size_t)nxt.pn * tstep + (size_t)nxt.k0 * kstep : cB;
        const int nt = cur.nk;
        for (int t = 0; t < nt; t += 2) {
            const bool last = (t == nt - 2);
            const char* a1 = cA + (size_t)(t + 1) * kstep;
            const char* a2 = last ? nA : cA + (size_t)(t + 2) * kstep; const char* b2 = last ? nB : cB + (size_t)(t + 2) * kstep;
            const char* a3 = a2 + kstep; const char* b3 = b2 + kstep;
            if (last && has_next) S.a_ready(nxt);
            if constexpr (SP2) {
            PG8_LDB(B0, 0, 0); PG8_LDB(B1, 0, 1); PG8_SCHED; PG8_LDA(At, 0, 0); PG8_STAGE(PG8_SA(1, 1), a1 + hstep, voffA);
            PG8_WAIT_V(8); PG8_WAIT_L(0); PG8_BAR; PG8_MMA(0, 0, At, B0); PG8_MMA(0, 1, At, B1); PG8_BAR; PG8_SCHED;
            PG8_LDA(At, 0, 1); PG8_STAGE(PG8_SB(0, 0), b2, voffB); PG8_STAGE(PG8_SB(0, 1), b2 + hstep, voffB); PG8_STAGE(PG8_SA(0, 0), a2, voffA);
            PG8_WAIT_V(8); PG8_WAIT_L(0); PG8_BAR; PG8_MMA(1, 0, At, B0); PG8_MMA(1, 1, At, B1); PG8_BAR; PG8_SCHED;
            PG8_LDB(B0, 1, 0); PG8_LDB(B1, 1, 1); PG8_SCHED; PG8_LDA(At, 1, 0); PG8_STAGE(PG8_SA(0, 1), a2 + hstep, voffA);
            PG8_WAIT_V(8); PG8_WAIT_L(0); PG8_BAR; PG8_MMA(0, 0, At, B0); PG8_MMA(0, 1, At, B1); PG8_BAR; PG8_SCHED;
            PG8_LDA(At, 1, 1); PG8_STAGE(PG8_SB(1, 0), b3, voffB); PG8_STAGE(PG8_SB(1, 1), b3 + hstep, voffB); PG8_STAGE(PG8_SA(1, 0), a3, voffA);
            PG8_WAIT_V(8); PG8_WAIT_L(0); PG8_BAR; PG8_MMA(1, 0, At, B0); PG8_MMA(1, 1, At, B1); PG8_BAR; PG8_SCHED;
            } else {
            PG8_LDB(B0, 0, 0); PG8_SCHED; PG8_LDA(At, 0, 0); PG8_STAGE(PG8_SA(1, 1), a1 + hstep, voffA);
            PG8_WAIT_L(8); PG8_BAR; PG8_WAIT_L(0); PG8_MMA(0, 0, At, B0); PG8_BAR; PG8_SCHED;
            PG8_LDB(B1, 0, 1); PG8_STAGE(PG8_SB(0, 0), b2, voffB);
            PG8_BAR; PG8_WAIT_L(0); PG8_MMA(0, 1, At, B1); PG8_BAR;
            PG8_LDA(At, 0, 1); PG8_STAGE(PG8_SA(0, 0), a2, voffA);
            PG8_BAR; PG8_WAIT_L(0); PG8_MMA(1, 0, At, B0); PG8_BAR; PG8_SCHED;
            PG8_STAGE(PG8_SB(0, 1), b2 + hstep, voffB);
            PG8_WAIT_V(6); PG8_BAR; PG8_MMA(1, 1, At, B1); PG8_BAR;
            PG8_LDB(B0, 1, 0); PG8_SCHED; PG8_LDA(At, 1, 0); PG8_STAGE(PG8_SA(0, 1), a2 + hstep, voffA);
            PG8_WAIT_L(8); PG8_BAR; PG8_WAIT_L(0); PG8_MMA(0, 0, At, B0); PG8_BAR; PG8_SCHED;
            PG8_LDB(B1, 1, 1); PG8_STAGE(PG8_SB(1, 0), b3, voffB);
            PG8_BAR; PG8_WAIT_L(0); PG8_MMA(0, 1, At, B1); PG8_BAR;
            PG8_LDA(At, 1, 1); PG8_STAGE(PG8_SA(1, 0), a3, voffA);
            PG8_BAR; PG8_WAIT_L(0); PG8_MMA(1, 0, At, B0); PG8_BAR; PG8_SCHED;
            PG8_STAGE(PG8_SB(1, 1), b3 + hstep, voffB);
            PG8_WAIT_V(6); PG8_BAR; PG8_MMA(1, 1, At, B1); PG8_BAR;
            }
        }
        if constexpr (ALIGN_EPI) { if (wr == 0) PG8_BAR; }
        if constexpr (F8) asm volatile("s_nop 15\n\ts_nop 15" ::: "memory");
        if (!cur.split) { E(acc, cur, wr, wc, fr, fq, 0xffffu); }
        if (!has_next) break;
#pragma unroll
        for (int a = 0; a < 2; ++a)
#pragma unroll
            for (int b = 0; b < 2; ++b)
#pragma unroll
                for (int m = 0; m < 4; ++m)
#pragma unroll
                    for (int n = 0; n < 2; ++n) acc[a][b][m][n] = (f32x4){0.f, 0.f, 0.f, 0.f};
        cur = nxt; cA = nA; cB = nB; ++ui;
        if constexpr (ALIGN_EPI) { if (wr == 1) PG8_BAR; }
    }
    PG8_WAIT_V(0);
    if constexpr (!ALIGN_EPI) { if (wr == 0) PG8_BAR; }
    PG8_BAR;
    if (cur.split) {
        const __amdgpu_buffer_rsrc_t rs = __builtin_amdgcn_make_buffer_rsrc((void*)(S.slab + (size_t)S.c * SLAB_BYTES), (short)0, (int)SLAB_BYTES, 0x00020000);
#pragma unroll
        for (int ai = 0; ai < 2; ++ai)
#pragma unroll
            for (int m = 0; m < 4; ++m)
#pragma unroll
                for (int bj = 0; bj < 2; ++bj) { const f32x4 a0 = acc[ai][bj][m][0], a1 = acc[ai][bj][m][1]; u32x4 w; w.x = cvtpk(a0[0], a0[1]); w.y = cvtpk(a0[2], a0[3]); w.z = cvtpk(a1[0], a1[1]); w.w = cvtpk(a1[2], a1[3]);
                    __builtin_amdgcn_raw_buffer_store_b128(w, rs, tid * 16, (((ai * 4 + m) * 2 + bj) * 512) * 16, 16); }
        asm volatile("s_waitcnt vmcnt(0)" ::: "memory"); PG8_BAR;
        unsigned* cnt = S.cnt + 32 * cur.tile;
        if (tid == 0) __hip_atomic_fetch_add(cnt, 1u, __ATOMIC_RELAXED, __HIP_MEMORY_SCOPE_AGENT);
        const int R = cur.S < 16 ? cur.S : 16;
        if (cur.s < R) {
            if (wid == 0) { unsigned polls = 0;
                while ((unsigned)__builtin_amdgcn_readfirstlane(__hip_atomic_load(cnt, __ATOMIC_RELAXED, __HIP_MEMORY_SCOPE_AGENT)) < (unsigned)cur.S) { __builtin_amdgcn_s_sleep(2); if (++polls > (1u << 22)) break; }
                __builtin_amdgcn_fence(__ATOMIC_ACQUIRE, "agent"); asm volatile("s_waitcnt vmcnt(0)" ::: "memory"); }
            asm volatile("" ::: "memory"); PG8_BAR; asm volatile("" ::: "memory");
            unsigned mask = 0u;
#pragma unroll
            for (int p = 0; p < 16; ++p) if ((p % R) == cur.s) { mask |= 1u << p;
                f32x4 s0 = (f32x4){0.f, 0.f, 0.f, 0.f}, s1 = (f32x4){0.f, 0.f, 0.f, 0.f};
                for (int s2 = 0; s2 < cur.S; s2 += 4) {
                    u32x4 v[4];
#pragma unroll
                    for (int j = 0; j < 4; ++j) { const int sj = (s2 + j < cur.S) ? s2 + j : cur.s;
                        const __amdgpu_buffer_rsrc_t rp = __builtin_amdgcn_make_buffer_rsrc((void*)(S.slab + (size_t)(cur.xw + 8 * sj * cur.rx) * SLAB_BYTES), (short)0, (int)SLAB_BYTES, 0x00020000);
                        v[j] = __builtin_amdgcn_raw_buffer_load_b128(rp, tid * 16, p * 512 * 16, 0); }
#pragma unroll
                    for (int j = 0; j < 4; ++j) if (s2 + j < cur.S) {
                        s0[0] += __uint_as_float(v[j].x << 16); s0[1] += __uint_as_float(v[j].x & 0xffff0000u); s0[2] += __uint_as_float(v[j].y << 16); s0[3] += __uint_as_float(v[j].y & 0xffff0000u);
                        s1[0] += __uint_as_float(v[j].z << 16); s1[1] += __uint_as_float(v[j].z & 0xffff0000u); s1[2] += __uint_as_float(v[j].w << 16); s1[3] += __uint_as_float(v[j].w & 0xffff0000u); } }
                acc[p >> 3][p & 1][(p >> 1) & 3][0] = s0; acc[p >> 3][p & 1][(p >> 1) & 3][1] = s1; }
            E(acc, cur, wr, wc, fr, fq, mask);
        }
    }
#undef PG8_SA
#undef PG8_SB
#undef PG8_STAGE
#undef PG8_LDA
#undef PG8_LDB
#undef PG8_MMA
#undef PG8_WAIT_V
#undef PG8_WAIT_L
#undef PG8_BAR
#undef PG8_SCHED
}
}
#define GAS __attribute__((address_space(1)))
#define LAS __attribute__((address_space(3)))
typedef unsigned short bf16;
typedef unsigned v4u __attribute__((ext_vector_type(4)));
typedef unsigned v2u __attribute__((ext_vector_type(2)));
typedef float f32x4 __attribute__((ext_vector_type(4)));
typedef short bf16x8 __attribute__((ext_vector_type(8)));
typedef short s16x4 __attribute__((ext_vector_type(4)));
typedef GAS unsigned gu32;
#define LDS_WAIT() asm volatile("s_waitcnt lgkmcnt(0)" ::: "memory")
#define VM_WAIT() asm volatile("s_waitcnt vmcnt(0)" ::: "memory")
using pg8::cvtpk;
__device__ __forceinline__ float bf_lo(unsigned w) { return __uint_as_float(w << 16); }
__device__ __forceinline__ float bf_hi(unsigned w) { return __uint_as_float(w & 0xffff0000u); }
__device__ __forceinline__ float wave_sum(float v) {
#pragma unroll
    for (int o = 1; o < 64; o <<= 1) v += __shfl_xor(v, o);
    return v;
}
__device__ __forceinline__ bf16x8 mk8(v4u a) { return __builtin_bit_cast(bf16x8, a); }
#define MFMA16(a, b, c) __builtin_amdgcn_mfma_f32_16x16x32_bf16((a), (b), (c), 0, 0, 0)
#define XB_TMO      128
#define XB_XCNT(j)  (256  + 64 * (j))
#define XB_XSUB(j)  (1280 + 64 * (j))
#define XB_XGEN(j)  (2304 + 64 * (j))
#define XB_TOP      3328
#define XB_TOPGEN   3392
#define XCD_BAR_WORDS 3456
#define XB_SPIN_CAP (1u << 18)

__device__ __forceinline__ unsigned xb_ld(unsigned* p)              { return __hip_atomic_load(p, __ATOMIC_RELAXED, __HIP_MEMORY_SCOPE_AGENT); }
__device__ __forceinline__ unsigned xb_add(unsigned* p, unsigned v) { return __hip_atomic_fetch_add(p, v, __ATOMIC_RELAXED, __HIP_MEMORY_SCOPE_AGENT); }
__device__ __forceinline__ unsigned xb_xcc_id() { return (unsigned)__builtin_amdgcn_s_getreg((3 << 11) | 20) & 0xFu; }
#define XB_SPIN(cond, bar) do { unsigned _sp = 0; while (cond) { __builtin_amdgcn_s_sleep(1); \
    if ((++_sp & 255u) == 0u) { if (xb_ld(&(bar)[XB_TMO])) break; if (_sp > XB_SPIN_CAP) { atomicAdd(&(bar)[XB_TMO], 1u); break; } } } } while (0)

struct XcdBarrier {
    unsigned* bar; unsigned x;
    volatile LAS unsigned* st;
};

__device__ __forceinline__ XcdBarrier xcd_barrier_post(unsigned* bar, volatile LAS unsigned* st) {
    XcdBarrier b; b.bar = bar; b.x = xb_xcc_id(); b.st = st;
    if (threadIdx.x == 0) (void)xb_add(&bar[XB_XCNT(b.x)], 1u);
    return b;
}
__device__ __forceinline__ void xcd_barrier_complete(unsigned* bar, unsigned x, unsigned& nloc, unsigned& nx) {
    const unsigned G = gridDim.x * gridDim.y * gridDim.z;
    unsigned sum, cnt, mine, sp = 0u;
    for (;;) {
        sum = 0u; cnt = 0u; mine = 0u;
#pragma unroll
        for (unsigned j = 0; j < 16; ++j) { const unsigned c = xb_ld(&bar[XB_XCNT(j)]); sum += c; cnt += (c > 0u) ? 1u : 0u; mine = (j == x) ? c : mine; }
        if (sum == G) break;
        __builtin_amdgcn_s_sleep(1);
        if ((++sp & 255u) == 0u) { if (xb_ld(&bar[XB_TMO])) break; if (sp > XB_SPIN_CAP) { atomicAdd(&bar[XB_TMO], 1u); break; } }
    }
    nloc = mine > 0u ? mine : 1u; nx = cnt > 0u ? cnt : 1u;
}

__device__ __forceinline__ void xcd_barrier(const XcdBarrier& b) {
    asm volatile("s_waitcnt vmcnt(0)" ::: "memory");
    __syncthreads();
    if (threadIdx.x == 0) {
        unsigned* bar = b.bar;
        __builtin_amdgcn_s_waitcnt(0);
        unsigned nloc = b.st[0], nx = b.st[1];
        if (nloc == 0u) { xcd_barrier_complete(bar, b.x, nloc, nx); b.st[0] = nloc; b.st[1] = nx; }
        const unsigned old = xb_add(&bar[XB_XSUB(b.x)], 1u);
        const unsigned gen = old / nloc;
        if (old + 1u == (gen + 1u) * nloc) {
            __builtin_amdgcn_fence(__ATOMIC_RELEASE, "agent");
            asm volatile("s_waitcnt vmcnt(0)" ::: "memory");
            const unsigned og = xb_add(&bar[XB_TOP], 1u);
            const unsigned tg = og / nx;
            if (og + 1u == (tg + 1u) * nx) xb_add(&bar[XB_TOPGEN], 1u);
            else XB_SPIN(xb_ld(&bar[XB_TOPGEN]) == tg, bar);
            __builtin_amdgcn_fence(__ATOMIC_ACQUIRE, "agent");
            xb_add(&bar[XB_XGEN(b.x)], 1u);
            asm volatile("s_waitcnt vmcnt(0)" ::: "memory");
        } else {
            XB_SPIN(xb_ld(&bar[XB_XGEN(b.x)]) == gen, bar);
            __builtin_amdgcn_fence(__ATOMIC_ACQUIRE, "agent");
            asm volatile("s_waitcnt vmcnt(0)" ::: "memory");
        }
    }
    __syncthreads();
}

struct Args { const float* in[27]; float* out; unsigned char* ws; int ph_lo, ph_hi; };
struct Frame {
    LAS unsigned char* lds; volatile LAS unsigned* MISC;
    int tid, lane, wave, vcu, G;
    const Args* a;
};
#define A_IN(k) (F.a->in[k])
#define A_WS(T, off) ((T*)(F.a->ws + (off)))
#define A_OUT (F.a->out)
#define A_XF (F.a->out + OUT_Y)
#define A_SSQ(k) ((unsigned long long*)(F.a->ws + CTL_SSQ_BYTE) + (size_t)(k) * M)

template <bool F8>
__device__ __forceinline__ void p0_load(const float* W, int ldn, const float* gain, int k0, int n0, int lane, f32x4 (&va)[8], f32x4 (&vb)[8], float (&ga)[8], float (&gb)[8]) {
    const int nq = lane & 15, kr = lane >> 4; const float gsc = F8 ? 64.f : 1.f;
#pragma unroll
    for (int j = 0; j < 8; ++j) { const int ka = k0 + 8 * j + 2 * kr;
        va[j] = *(const f32x4*)(W + (size_t)ka * ldn + n0 + 4 * nq); vb[j] = *(const f32x4*)(W + (size_t)(ka + 1) * ldn + n0 + 4 * nq);
        ga[j] = gain ? gain[ka] * gsc : gsc; gb[j] = gain ? gain[ka + 1] * gsc : gsc; }
}
template <int MODE, bool F8>
__device__ __forceinline__ void p0_store(int ldk, bf16* WT, LAS unsigned char* scr, int k0, int n0, int lane, const f32x4 (&va)[8], const f32x4 (&vb)[8], const float (&ga)[8], const float (&gb)[8]) {
    const int nq = lane & 15, kr = lane >> 4;
#pragma unroll
    for (int j = 0; j < 8; ++j)
#pragma unroll
        for (int e = 0; e < 4; ++e) *(LAS unsigned*)(scr + (4 * nq + e) * 128 + ((j ^ (nq & 7)) << 4) + 4 * kr) = cvtpk(va[j][e] * ga[j], vb[j][e] * gb[j]);
    LDS_WAIT(); asm volatile("" ::: "memory");
#pragma unroll
    for (int i = 0; i < 8; ++i) {
        const int n = (lane >> 3) + 8 * i, c = lane & 7;
        const v4u o = *(const LAS v4u*)(scr + n * 128 + ((c ^ ((n >> 2) & 7)) << 4));
        const int nn = n0 + n;
        const int r = (MODE == 0) ? nn : (32 * (nn >> 4) + (nn & 15) + (MODE == 2 ? 16 : 0));
        if constexpr (F8) { v2u q; q.x = pg8::pack4_fp8(bf_lo(o.x), bf_hi(o.x), bf_lo(o.y), bf_hi(o.y)); q.y = pg8::pack4_fp8(bf_lo(o.z), bf_hi(o.z), bf_lo(o.w), bf_hi(o.w));
            *(v2u*)((unsigned char*)WT + (size_t)r * ldk + k0 + 8 * c) = q; }
        else *(v4u*)(WT + (size_t)r * ldk + k0 + 8 * c) = o;
    }
    LDS_WAIT(); asm volatile("" ::: "memory");
}
template <int MODE, bool F8 = false>
__device__ __forceinline__ void p0_matrix(Frame& F, const float* W, int K, int ldn, int ncols, const float* gain, bf16* WT, int gw, int NGW) {
    LAS unsigned char* scr = F.lds + F.wave * 18432;
    const int ntn = ncols / 64, nt = (K / 64) * ntn;
    const int ldk = (K == D) ? LDX : (K == FFN ? LDH : K);
    for (int it = 2 * gw; it < nt; it += 2 * NGW) { const int it2 = it + 1;
        f32x4 va[8], vb[8], wa[8], wb[8]; float ga[8], gb[8], ha[8], hb[8];
        p0_load<F8>(W, ldn, gain, (it / ntn) * 64, (it % ntn) * 64, F.lane, va, vb, ga, gb);
        if (it2 < nt) p0_load<F8>(W, ldn, gain, (it2 / ntn) * 64, (it2 % ntn) * 64, F.lane, wa, wb, ha, hb);
        p0_store<MODE, F8>(ldk, WT, scr, (it / ntn) * 64, (it % ntn) * 64, F.lane, va, vb, ga, gb);
        if (it2 < nt) p0_store<MODE, F8>(ldk, WT, scr, (it2 / ntn) * 64, (it2 % ntn) * 64, F.lane, wa, wb, ha, hb); }
}
__device__ __forceinline__ void p0_late_weights(Frame& F, int gw, int NGW) {
    p0_matrix<0>(F, A_IN(18), D, D, D, nullptr, A_WS(bf16, WS_WOUT), gw, NGW);
    p0_matrix<1, true>(F, A_IN(20), D, FFN, FFN, A_IN(19), A_WS(bf16, WS_W2GU), gw, NGW);
    p0_matrix<2, true>(F, A_IN(21), D, FFN, FFN, A_IN(19), A_WS(bf16, WS_W2GU), gw, NGW);
    p0_matrix<0, true>(F, A_IN(22), FFN, D, D, nullptr, A_WS(bf16, WS_W2D), gw, NGW);
}
__device__ __forceinline__ void p0_ple_weights(Frame& F, int gw, int NGW) {
    p0_matrix<0, true>(F, A_IN(24), D, D, D, A_IN(23), A_WS(bf16, WS_WPG), gw, NGW);
}
__device__ __forceinline__ void p0_prologue(Frame& F) {
    const int gw = F.vcu * NWAVES + F.wave, NGW = F.G * NWAVES;
    p0_matrix<1>(F, A_IN(10), D, FFN, FFN, A_IN(9), A_WS(bf16, WS_W1GU), gw, NGW);
    p0_matrix<2>(F, A_IN(11), D, FFN, FFN, A_IN(9), A_WS(bf16, WS_W1GU), gw, NGW);
    p0_matrix<0>(F, A_IN(12), FFN, D, D, nullptr, A_WS(bf16, WS_W1D), gw, NGW);
    p0_matrix<0>(F, A_IN(14), D, NINF, NIN, A_IN(13), A_WS(bf16, WS_WIN), gw, NGW);
    p0_matrix<0>(F, A_IN(25), PLE, D, D, nullptr, A_WS(bf16, WS_WPP), gw, NGW);
    for (int row = gw; row < M; row += NGW) {
        const float* src = row < MP ? A_IN(0) + (size_t)row * D : A_IN(1) + (size_t)(row - MP) * D;
        const f32x4* xr = (const f32x4*)src + F.lane; v2u* o = (v2u*)(A_WS(bf16, WS_XB) + (size_t)row * LDX) + F.lane; float s = 0.f;
#pragma unroll
        for (int j = 0; j < 16; ++j) { const f32x4 v = xr[64 * j]; s += (v[0] * v[0] + v[1] * v[1]) + (v[2] * v[2] + v[3] * v[3]); v2u w; w.x = cvtpk(v[0], v[1]); w.y = cvtpk(v[2], v[3]); o[64 * j] = w; }
        s = wave_sum(s);
        if (F.lane == 0) A_SSQ(0)[row] = pg8::ssq_fix(s);
    }
    const int gt = F.vcu * NWAVES * 64 + F.tid, NGT = F.G * NWAVES * 64;
    for (int i = gt; i < M * (PLE / 4); i += NGT) {
        const f32x4 v = (i < MP * (PLE / 4)) ? ((const f32x4*)A_IN(7))[i] : ((const f32x4*)A_IN(8))[i - MP * (PLE / 4)];
        v2u w; w.x = cvtpk(v[0], v[1]); w.y = cvtpk(v[2], v[3]); ((v2u*)A_WS(bf16, WS_PB))[i] = w;
    }
    for (int i = gt; i < 8 * D; i += NGT) { const int j = i / D, k = i % D; A_WS(float, WS_WIF)[i] = A_IN(13)[k] * A_IN(14)[(size_t)k * NINF + NIN + j]; }
}

__device__ __forceinline__ void gates_rows(Frame& F) {
    const int gw = F.vcu * NWAVES + F.wave, NGW = F.G * NWAVES;
    float acc[5][8];
#pragma unroll
    for (int r = 0; r < 5; ++r)
#pragma unroll
        for (int jj = 0; jj < 8; ++jj) acc[r][jj] = 0.f;
    for (int j = 0; j < 16; ++j) {
        f32x4 wv[8];
#pragma unroll
        for (int jj = 0; jj < 8; ++jj) wv[jj] = *(const f32x4*)(A_WS(float, WS_WIF) + jj * D + 256 * j + 4 * F.lane);
#pragma unroll
        for (int r = 0; r < 5; ++r) { const int row = gw + NGW * r;
            if (row < M) { const v2u xw = *(const v2u*)(A_WS(bf16, WS_XB) + (size_t)row * D + 256 * j + 4 * F.lane); f32x4 x; x[0] = bf_lo(xw.x); x[1] = bf_hi(xw.x); x[2] = bf_lo(xw.y); x[3] = bf_hi(xw.y);
#pragma unroll
                for (int jj = 0; jj < 8; ++jj) acc[r][jj] += (x[0] * wv[jj][0] + x[1] * wv[jj][1]) + (x[2] * wv[jj][2] + x[3] * wv[jj][3]); } }
    }
#pragma unroll
    for (int r = 0; r < 5; ++r) { const int row = gw + NGW * r;
        if (row < M) { const float rs = pg8::rs_of(A_SSQ(1), row);
#pragma unroll
            for (int jj = 0; jj < 8; ++jj) { const float s = wave_sum(acc[r][jj]); if (F.lane == jj) A_WS(float, WS_GATES)[(size_t)row * 8 + jj] = s * rs + A_IN(15)[jj]; } } }
}

__device__ __forceinline__ bf16x8 cvt8(const f32x4 a, const f32x4 b) { v4u w; w.x = cvtpk(a[0], a[1]); w.y = cvtpk(a[2], a[3]); w.z = cvtpk(b[0], b[1]); w.w = cvtpk(b[2], b[3]); return mk8(w); }
__device__ __forceinline__ s16x4 tr16(LAS unsigned char* p) { typedef short v4i16_t __attribute__((ext_vector_type(4))); return __builtin_bit_cast(s16x4, __builtin_amdgcn_ds_read_tr16_b64_v4i16((LAS v4i16_t*)p)); }
constexpr int SB_VLD = 288, SB_VBYTES = 64 * SB_VLD;
__device__ __forceinline__ void sb_unit(Frame& F, int unit, LAS unsigned char* vl) {
    const int lane = F.lane, i16 = lane & 15, g = lane >> 4;
    const int h = unit & 15, qrow0 = (unit >> 4) * 16;
    const bool samp = qrow0 >= MP;
    int pos0, krow_base; const float* ck = nullptr; const float* cv = nullptr;
    if (!samp) { pos0 = qrow0 & (SEQ - 1); krow_base = qrow0 - pos0; }
    else { const int bs = (qrow0 - MP) >> 5; pos0 = PAST + ((qrow0 - MP) & 31); krow_base = MP + bs * DSEQ - PAST;
           ck = A_IN(2) + (size_t)bs * PAST * SBW + h * SBD; cv = A_IN(3) + (size_t)bs * PAST * SBW + h * SBD; }
    const int qpos = pos0 + i16;
    bf16x8 qf[4];
#pragma unroll
    for (int ks = 0; ks < 4; ++ks) qf[ks] = *(const bf16x8*)(A_WS(bf16, WS_QB) + (size_t)(qrow0 + i16) * SBW + h * SBD + 32 * ks + 8 * g);
    f32x4 o[8];
#pragma unroll
    for (int d = 0; d < 8; ++d) o[d] = (f32x4){0.f, 0.f, 0.f, 0.f};
    float P = 1.0f;
    for (int kend = pos0 + 16; kend > 0; kend -= 64) {
        const int kbase = kend - 64;
        f32x4 beta[4], omb[4];
        if (!samp) {
            v4u vv[16]; bf16x8 kf[4][4];
#pragma unroll
            for (int i = 0; i < 16; ++i) { const int key = (lane >> 4) + 4 * i, dc = lane & 15; int pos = kbase + key; pos = pos < 0 ? 0 : pos;
                vv[i] = *(const v4u*)(A_WS(bf16, WS_VB) + (size_t)(krow_base + pos) * SBW + h * SBD + 8 * dc); }
#pragma unroll
            for (int kt = 0; kt < 4; ++kt) { int t0 = kbase + 16 * kt; t0 = t0 < 0 ? 0 : t0;
#pragma unroll
                for (int ks = 0; ks < 4; ++ks) kf[kt][ks] = *(const bf16x8*)(A_WS(bf16, WS_KB) + (size_t)(krow_base + t0 + i16) * SBW + h * SBD + 32 * ks + 8 * g); }
#pragma unroll
            for (int i = 0; i < 16; ++i) { const int key = (lane >> 4) + 4 * i, dc = lane & 15; *(LAS v4u*)(vl + key * SB_VLD + dc * 16) = vv[i]; }
#pragma unroll
            for (int kt = 0; kt < 4; ++kt) { const int t0 = kbase + 16 * kt;
                f32x4 acc = (f32x4){0.f, 0.f, 0.f, 0.f};
#pragma unroll
                for (int ks = 0; ks < 4; ++ks) acc = MFMA16(kf[kt][ks], qf[ks], acc);
#pragma unroll
                for (int r = 0; r < 4; ++r) { const float z = acc[r]; const float e = __expf(-fabsf(z)); const float rr = __builtin_amdgcn_rcpf(1.0f + e), er = e * rr;
                    const bool ok = t0 >= 0 && (t0 + 4 * g + r) < qpos;
                    beta[kt][r] = ok ? (z >= 0.f ? rr : er) : 0.f; omb[kt][r] = ok ? (z >= 0.f ? er : rr) : 1.f; } }
        } else {
#pragma unroll
        for (int i = 0; i < 16; ++i) {
            const int key = (lane >> 4) + 4 * i, dc = lane & 15; int pos = kbase + key; pos = pos < 0 ? 0 : pos;
            v4u val;
            if (samp && (kbase + 4 * i) < PAST) { const float* p = cv + (size_t)pos * SBW + 8 * dc; const f32x4 a = *(const f32x4*)p, b = *(const f32x4*)(p + 4); val = __builtin_bit_cast(v4u, cvt8(a, b)); }
            else val = *(const v4u*)(A_WS(bf16, WS_VB) + (size_t)(krow_base + pos) * SBW + h * SBD + 8 * dc);
            *(LAS v4u*)(vl + key * SB_VLD + dc * 16) = val;
        }
#pragma unroll
        for (int kt = 0; kt < 4; ++kt) {
            const int t0 = kbase + 16 * kt;
            if (t0 < 0) { beta[kt] = (f32x4){0.f, 0.f, 0.f, 0.f}; omb[kt] = (f32x4){1.f, 1.f, 1.f, 1.f}; continue; }
            f32x4 acc = (f32x4){0.f, 0.f, 0.f, 0.f};
            if (samp && t0 < PAST) {
#pragma unroll
                for (int ks = 0; ks < 4; ++ks) { const float* p = ck + (size_t)(t0 + i16) * SBW + 32 * ks + 8 * g; const f32x4 a = *(const f32x4*)p, b = *(const f32x4*)(p + 4);
                    acc = MFMA16(cvt8(a, b), qf[ks], acc); }
            } else {
#pragma unroll
                for (int ks = 0; ks < 4; ++ks) { const bf16x8 kf = *(const bf16x8*)(A_WS(bf16, WS_KB) + (size_t)(krow_base + t0 + i16) * SBW + h * SBD + 32 * ks + 8 * g); acc = MFMA16(kf, qf[ks], acc); }
            }
#pragma unroll
            for (int r = 0; r < 4; ++r) { const float z = acc[r]; const float e = __expf(-fabsf(z)); const float rr = __builtin_amdgcn_rcpf(1.0f + e), er = e * rr;
                const bool ok = (t0 + 4 * g + r) < qpos;
                beta[kt][r] = ok ? (z >= 0.f ? rr : er) : 0.f; omb[kt][r] = ok ? (z >= 0.f ? er : rr) : 1.f; }
        }
        }
        f32x4 a[4]; float Pc = P;
#pragma unroll
        for (int kt = 3; kt >= 0; --kt) {
            const float s2 = omb[kt][3], s1 = s2 * omb[kt][2], s0 = s1 * omb[kt][1], T = s0 * omb[kt][0];
            const float x1 = __shfl_xor(T, 16), x2 = __shfl_xor(T, 32), x3 = __shfl_xor(T, 48);
            const float Sg = (((g ^ 1) > g) ? x1 : 1.f) * (((g ^ 2) > g) ? x2 : 1.f) * (((g ^ 3) > g) ? x3 : 1.f);
            const float base = Sg * Pc;
            a[kt][0] = beta[kt][0] * s0 * base; a[kt][1] = beta[kt][1] * s1 * base; a[kt][2] = beta[kt][2] * s2 * base; a[kt][3] = beta[kt][3] * base;
            Pc *= (T * x1) * (x2 * x3);
        }
        P = Pc;
#pragma unroll
        for (int ks2 = 0; ks2 < 2; ++ks2) {
            const bf16x8 af = cvt8(a[2 * ks2], a[2 * ks2 + 1]);
#pragma unroll
            for (int d = 0; d < 8; ++d) {
                LAS unsigned char* p = vl + (32 * ks2 + 4 * g + (i16 >> 2)) * SB_VLD + (16 * d + 4 * (i16 & 3)) * 2;
                const s16x4 lo = tr16(p), hi = tr16(p + 16 * SB_VLD);
                const bf16x8 vf = __builtin_shufflevector(lo, hi, 0, 1, 2, 3, 4, 5, 6, 7);
                o[d] = MFMA16(vf, af, o[d]);
            }
        }
        if (__all(P < 7.8886090522101181e-31f)) break;
    }
    float ss = 0.f;
#pragma unroll
    for (int d = 0; d < 8; ++d) ss += (o[d][0] * o[d][0] + o[d][1] * o[d][1]) + (o[d][2] * o[d][2] + o[d][3] * o[d][3]);
    ss += __shfl_xor(ss, 16); ss += __shfl_xor(ss, 32);
    const float rinv = rsqrtf(ss * (1.0f / SBD) + EPS);
    bf16* mrow = A_WS(bf16, WS_MIX) + (size_t)(qrow0 + i16) * LDX + h * SBD + 4 * g;
#pragma unroll
    for (int d = 0; d < 8; ++d) { const f32x4 gv = *(const f32x4*)(A_IN(16) + h * SBD + 16 * d + 4 * g);
        v2u w; w.x = cvtpk(o[d][0] * rinv * gv[0], o[d][1] * rinv * gv[1]); w.y = cvtpk(o[d][2] * rinv * gv[2], o[d][3] * rinv * gv[3]); *(v2u*)(mrow + 16 * d) = w; }
}

constexpr int ML_QS = 0, ML_LD = 528, ML_KS = 33792, ML_TLD = 144, ML_VS = 67584, ML_VSS = 76800, ML_PS = 86016, ML_TAB = 95232;
__device__ __forceinline__ float scan_add(float v, int lane) {
#pragma unroll
    for (int o = 1; o < 64; o <<= 1) { const float t = __shfl_up(v, o); v = (lane >= o) ? v + t : v; }
    return v;
}
__device__ __forceinline__ float scan_max(float v, int lane) {
#pragma unroll
    for (int o = 1; o < 64; o <<= 1) { const float t = __shfl_up(v, o); v = (lane >= o) ? fmaxf(v, t) : v; }
    return v;
}
__device__ __forceinline__ void mlstm_scan(Frame& F, int seq, int h, int vblk, bool samp, bool doval, bool doden) {
    LAS unsigned char* L = F.lds; const int tid = F.tid, lane = F.lane, w = F.wave, i16 = lane & 15, g = lane >> 4;
    const int nsteps = samp ? 1 : SEQ / CHUNK, Lvalid = samp ? DSEQ : CHUNK;
    const int row0 = samp ? MP + seq * DSEQ : seq * SEQ, vbase = vblk * 64; const bool vw = w < 4;
    LAS float* tab = (LAS float*)(L + ML_TAB); LAS float* nvec = tab + 192; LAS float* dpart = tab + 448; LAS float* rsp = tab + 960;
    f32x4 C[16]; float m;
    if (samp) { const float* c0 = A_IN(4) + ((size_t)(seq * MLH + h) * MLV + vbase + 16 * (w & 3) + i16) * MLQK + 4 * g;
#pragma unroll
        for (int dt = 0; dt < 16; ++dt) C[dt] = *(const f32x4*)(c0 + 16 * dt);
        m = A_IN(6)[seq * MLH + h]; if (tid < MLQK) nvec[tid] = A_IN(5)[(seq * MLH + h) * MLQK + tid]; }
    else {
#pragma unroll
        for (int dt = 0; dt < 16; ++dt) C[dt] = (f32x4){0.f, 0.f, 0.f, 0.f};
        m = 0.f; if (tid < MLQK) nvec[tid] = 0.f; }
    v4u qreg[4], kreg[4], vreg; f32x4 sc4; float aav, wprev_n;
#define ML_PREFETCH(cc) do { const int rowc_ = row0 + CHUNK * (cc); \
        _Pragma("unroll") for (int i = 0; i < 4; ++i) { const int id = tid + 512 * i, r = id >> 5, c16 = id & 31; \
            if (r < Lvalid) { qreg[i] = *(const v4u*)(A_WS(bf16, WS_MQ) + (size_t)(rowc_ + r) * 1024 + h * MLQK + 8 * c16); kreg[i] = *(const v4u*)(A_WS(bf16, WS_MK) + (size_t)(rowc_ + r) * 1024 + h * MLQK + 8 * c16); } \
            else { qreg[i] = (v4u){0u, 0u, 0u, 0u}; kreg[i] = (v4u){0u, 0u, 0u, 0u}; } } \
        { const int r = tid >> 3, c8 = tid & 7; \
            if (r < Lvalid) vreg = *(const v4u*)(A_WS(bf16, WS_MV) + (size_t)(rowc_ + r) * 2048 + h * MLV + vbase + 8 * c8); else vreg = (v4u){0u, 0u, 0u, 0u}; } \
        sc4 = *(const f32x4*)(GS + ((size_t)(cc) * 64 + lane) * 4); aav = GS[16384 + (cc) * 64 + lane]; wprev_n = GS[20480 + (cc)]; } while (0)
    float* GS = A_WS(float, WS_MLS) + (size_t)blockIdx.x * 21504;
    {   LAS float* ptab = (LAS float*)(L + ML_QS);
        float pb[8], pa[8], pA[8];
#pragma unroll
        for (int k = 0; k < 8; ++k) { const int cc = w + 8 * k; pb[k] = 0.f; pa[k] = -INFINITY; pA[k] = -INFINITY;
            if (cc < nsteps) { float gi, gf; const int rowc_ = row0 + CHUNK * cc;
                if (lane < Lvalid) { gi = A_WS(float, WS_GATES)[(size_t)(rowc_ + lane) * 8 + h]; gf = A_WS(float, WS_GATES)[(size_t)(rowc_ + lane) * 8 + 4 + h]; } else { gi = -INFINITY; gf = 1e30f; }
                const float lf = fminf(gf, 0.f) - log1pf(expf(-fabsf(gf)));
                pb[k] = scan_add(lf, lane); pa[k] = gi - pb[k]; pA[k] = scan_max(pa[k], lane);
                if (lane == Lvalid - 1) { ptab[2 * cc] = pb[k]; ptab[2 * cc + 1] = pA[k]; } } }
        __syncthreads();
        const float Bc = lane < nsteps ? ptab[2 * lane] : 0.f, Ac = lane < nsteps ? ptab[2 * lane + 1] : -INFINITY;
        float mcur = m, mstart = m, mend = m;
        for (int cc = 0; cc < nsteps; ++cc) { const float mn = __shfl(Bc, cc) + fmaxf(mcur, __shfl(Ac, cc)); if (lane == cc) { mstart = mcur; mend = mn; } mcur = mn; }
        m = mcur;
#pragma unroll
        for (int k = 0; k < 8; ++k) { const int cc = w + 8 * k;
            if (cc < nsteps) { const float mc = __shfl(mstart, cc), mnew = __shfl(mend, cc), blast = __shfl(pb[k], Lvalid - 1);
                const float mrow = pb[k] + fmaxf(mc, pA[k]);
                f32x4 o; o[0] = expf(blast + pa[k] - mnew); o[1] = expf(pb[k] + mc - mrow); o[2] = expf(-mrow); o[3] = pb[k] - mrow;
                *(f32x4*)(GS + ((size_t)cc * 64 + lane) * 4) = o; GS[16384 + cc * 64 + lane] = pa[k];
                if (lane == 0) GS[20480 + cc] = expf(blast + mc - mnew); } }
        asm volatile("s_waitcnt vmcnt(0)" ::: "memory");
        __syncthreads(); }
    ML_PREFETCH(0);
    for (int c = 0; c < nsteps; ++c) {
        const int rowc = row0 + CHUNK * c;
        const float wtok = sc4[0], winter = sc4[1], emr = sc4[2], uu = sc4[3], aa = aav, wprev = wprev_n;
#pragma unroll
        for (int i = 0; i < 4; ++i) { const int id = tid + 512 * i, r = id >> 5, c16 = id & 31; *(LAS v4u*)(L + ML_QS + r * ML_LD + c16 * 16) = qreg[i]; *(LAS v4u*)(L + ML_KS + r * ML_LD + c16 * 16) = kreg[i]; }
        { const int r = tid >> 3, c8 = tid & 7; const float wt = __shfl(wtok, r);
            *(LAS v4u*)(L + ML_VS + r * ML_TLD + c8 * 16) = vreg;
            v4u sv; sv.x = cvtpk(bf_lo(vreg.x) * wt, bf_hi(vreg.x) * wt); sv.y = cvtpk(bf_lo(vreg.y) * wt, bf_hi(vreg.y) * wt); sv.z = cvtpk(bf_lo(vreg.z) * wt, bf_hi(vreg.z) * wt); sv.w = cvtpk(bf_lo(vreg.w) * wt, bf_hi(vreg.w) * wt);
            *(LAS v4u*)(L + ML_VSS + r * ML_TLD + c8 * 16) = sv; }
        if (w == 0) { tab[lane] = wtok; tab[64 + lane] = winter; tab[128 + lane] = emr; tab[1088 + lane] = uu; tab[1152 + lane] = aa; }
        if (c + 1 < nsteps) ML_PREFETCH(c + 1);
        __syncthreads();
#define SB0() __builtin_amdgcn_sched_barrier(0)
        {   if (!vw) { const int tt = w - 4; float rsum = 0.f; const float ut = tab[1088 + 16 * tt + i16];
            bf16x8 fq[8];
#pragma unroll
            for (int ks = 0; ks < 8; ++ks) fq[ks] = *(const LAS bf16x8*)(L + ML_QS + (16 * tt + i16) * ML_LD + (32 * ks + 8 * g) * 2);
#pragma unroll
            for (int st = 0; st < 4; ++st) { f32x4 acc = (f32x4){0.f, 0.f, 0.f, 0.f};
                if (st <= tt) { bf16x8 fk[8];
#pragma unroll
                    for (int ks = 0; ks < 8; ++ks) fk[ks] = *(const LAS bf16x8*)(L + ML_KS + (16 * st + i16) * ML_LD + (32 * ks + 8 * g) * 2);
                    SB0();
#pragma unroll
                    for (int ks = 0; ks < 8; ++ks) acc = MFMA16(fk[ks], fq[ks], acc);
                    SB0(); }
                f32x4 pv; const f32x4 as4 = *(const LAS f32x4*)(tab + 1152 + 16 * st + 4 * g);
#pragma unroll
                for (int r = 0; r < 4; ++r) { const float as = as4[r]; const bool ok = (st < tt) || (st == tt && (4 * g + r) <= i16); pv[r] = ok ? acc[r] * __expf(ut + as) : 0.f; }
                rsum += (pv[0] + pv[1]) + (pv[2] + pv[3]);
                v2u pw; pw.x = cvtpk(pv[0], pv[1]); pw.y = cvtpk(pv[2], pv[3]); *(LAS v2u*)(L + ML_PS + (16 * tt + i16) * ML_TLD + (16 * st + 4 * g) * 2) = pw; }
            rsum += __shfl_xor(rsum, 16); rsum += __shfl_xor(rsum, 32);
            if (g == 0) { rsp[(16 * tt + i16) * 2] = rsum; rsp[(16 * tt + i16) * 2 + 1] = 0.f; } }
            if (doden) { float dp = 0.f; v4u qq[4]; f32x4 nn0[4], nn1[4];
#pragma unroll
            for (int c4 = 0; c4 < 4; ++c4) { qq[c4] = *(const LAS v4u*)(L + ML_QS + lane * ML_LD + (32 * w + 8 * c4) * 2); nn0[c4] = *(const LAS f32x4*)(nvec + 32 * w + 8 * c4); nn1[c4] = *(const LAS f32x4*)(nvec + 32 * w + 8 * c4 + 4); }
#pragma unroll
            for (int c4 = 0; c4 < 4; ++c4) dp += (bf_lo(qq[c4].x) * nn0[c4][0] + bf_hi(qq[c4].x) * nn0[c4][1]) + (bf_lo(qq[c4].y) * nn0[c4][2] + bf_hi(qq[c4].y) * nn0[c4][3]) + (bf_lo(qq[c4].z) * nn1[c4][0] + bf_hi(qq[c4].z) * nn1[c4][1]) + (bf_lo(qq[c4].w) * nn1[c4][2] + bf_hi(qq[c4].w) * nn1[c4][3]);
            dpart[lane * 8 + w] = dp; } }
        f32x4 Y[4];
#pragma unroll
        for (int t2 = 0; t2 < 4; ++t2) Y[t2] = (f32x4){0.f, 0.f, 0.f, 0.f};
        if (vw && doval) {
#define ML_LDQ(dst, ks_) do { _Pragma("unroll") for (int t2 = 0; t2 < 4; ++t2) { const LAS unsigned char* qp = L + ML_QS + (16 * t2 + i16) * ML_LD + (32 * (ks_) + 4 * g) * 2; const v2u b0 = *(const LAS v2u*)qp, b1 = *(const LAS v2u*)(qp + 32); \
            dst[t2].x = b0.x; dst[t2].y = b0.y; dst[t2].z = b1.x; dst[t2].w = b1.y; } } while (0)
        v4u qa[4], qb[4];
        ML_LDQ(qa, 0);
#pragma unroll
        for (int ks = 0; ks < 8; ks += 2) {
            ML_LDQ(qb, ks + 1); SB0();
            { const bf16x8 af = cvt8(C[2 * ks], C[2 * ks + 1]);
#pragma unroll
              for (int t2 = 0; t2 < 4; ++t2) Y[t2] = MFMA16(af, mk8(qa[t2]), Y[t2]); }
            SB0();
            if (ks + 2 < 8) ML_LDQ(qa, ks + 2);
            SB0();
            { const bf16x8 af = cvt8(C[2 * ks + 2], C[2 * ks + 3]);
#pragma unroll
              for (int t2 = 0; t2 < 4; ++t2) Y[t2] = MFMA16(af, mk8(qb[t2]), Y[t2]); }
            SB0(); }
#undef ML_LDQ
#pragma unroll
        for (int t2 = 0; t2 < 4; ++t2) Y[t2] = Y[t2] * tab[64 + 16 * t2 + i16];
#pragma unroll
        for (int dt = 0; dt < 16; ++dt) C[dt] = C[dt] * wprev;
#pragma unroll
        for (int ks = 0; ks < 2; ++ks) { LAS unsigned char* tp = L + (32 * ks + 8 * g + (i16 >> 2)) * ML_TLD + (16 * w + 4 * (i16 & 3)) * 2;
            LAS unsigned char* kp = L + ML_KS + (32 * ks + 8 * g + (i16 >> 2)) * ML_LD + (4 * (i16 & 3)) * 2;
            const s16x4 blo = tr16(tp + ML_VSS), bhi = tr16(tp + ML_VSS + 4 * ML_TLD);
            const bf16x8 B = __builtin_shufflevector(blo, bhi, 0, 1, 2, 3, 4, 5, 6, 7);
#pragma unroll
            for (int dh = 0; dh < 16; dh += 8) { s16x4 alo[8], ahi[8];
#pragma unroll
                for (int dt = 0; dt < 8; ++dt) { alo[dt] = tr16(kp + 32 * (dh + dt)); ahi[dt] = tr16(kp + 32 * (dh + dt) + 4 * ML_LD); }
                SB0();
#pragma unroll
                for (int dt = 0; dt < 8; ++dt) { const bf16x8 A = __builtin_shufflevector(alo[dt], ahi[dt], 0, 1, 2, 3, 4, 5, 6, 7); C[dh + dt] = MFMA16(A, B, C[dh + dt]); }
                SB0(); } }
        }
        __syncthreads();
        if (vw && doval) {
            s16x4 alo[2], ahi[2]; bf16x8 pb[2][4];
#pragma unroll
            for (int ks = 0; ks < 2; ++ks) { LAS unsigned char* tp = L + ML_VS + (32 * ks + 8 * g + (i16 >> 2)) * ML_TLD + (16 * w + 4 * (i16 & 3)) * 2; alo[ks] = tr16(tp); ahi[ks] = tr16(tp + 4 * ML_TLD);
#pragma unroll
                for (int t2 = 0; t2 < 4; ++t2) pb[ks][t2] = *(const LAS bf16x8*)(L + ML_PS + (16 * t2 + i16) * ML_TLD + (32 * ks + 8 * g) * 2); }
            SB0();
#pragma unroll
            for (int ks = 0; ks < 2; ++ks) { const bf16x8 A = __builtin_shufflevector(alo[ks], ahi[ks], 0, 1, 2, 3, 4, 5, 6, 7);
#pragma unroll
                for (int t2 = 0; t2 < 4; ++t2) Y[t2] = MFMA16(A, pb[ks][t2], Y[t2]); }
            SB0();
#pragma unroll
        for (int t2 = 0; t2 < 4; ++t2) { const int t = 16 * t2 + i16; if (t < Lvalid) *(f32x4*)(A_WS(float, WS_NUM) + (size_t)(rowc + t) * 2048 + h * MLV + vbase + 16 * w + 4 * g) = Y[t2]; }
        }
        if (doden) { if (tid < CHUNK) { float dq = 0.f;
#pragma unroll
            for (int j = 0; j < 8; ++j) dq += dpart[tid * 8 + j];
            const float den = tab[64 + tid] * dq + rsp[2 * tid] + rsp[2 * tid + 1]; const float dd = fmaxf(fabsf(den), tab[128 + tid]);
            if (tid < Lvalid) A_WS(float, WS_DEN)[(size_t)(rowc + tid) * MLH + h] = dd; }
#pragma unroll
        for (int dd2 = 0; dd2 < 2; ++dd2) { const int dt = 2 * w + dd2; float an = 0.f;
#pragma unroll
            for (int sb = 0; sb < 4; ++sb) { const s16x4 kv = tr16(L + ML_KS + (16 * sb + 4 * g + (i16 >> 2)) * ML_LD + (16 * dt + 4 * (i16 & 3)) * 2); const f32x4 w4 = *(const LAS f32x4*)(tab + 16 * sb + 4 * g);
                an += (__uint_as_float((unsigned)(unsigned short)kv[0] << 16) * w4[0] + __uint_as_float((unsigned)(unsigned short)kv[1] << 16) * w4[1]) + (__uint_as_float((unsigned)(unsigned short)kv[2] << 16) * w4[2] + __uint_as_float((unsigned)(unsigned short)kv[3] << 16) * w4[3]); }
            an += __shfl_xor(an, 16); an += __shfl_xor(an, 32);
            if (g == 0) nvec[16 * dt + i16] = wprev * nvec[16 * dt + i16] + an; } }
        __syncthreads();
    }
#undef ML_PREFETCH
    float* oc = A_OUT + (samp ? OUT_MLC_S : OUT_MLC_P) + ((size_t)(seq * MLH + h) * MLV + vbase + 16 * (w & 3) + i16) * MLQK + 4 * g;
    if (vw && doval) {
#pragma unroll
    for (int dt = 0; dt < 16; ++dt) *(f32x4*)(oc + 16 * dt) = C[dt]; }
    if (doden) { if (tid < MLQK) A_OUT[(samp ? OUT_MLN_S : OUT_MLN_P) + (seq * MLH + h) * MLQK + tid] = nvec[tid]; if (tid == 0) A_OUT[(samp ? OUT_MLM_S : OUT_MLM_P) + seq * MLH + h] = m; }
    __syncthreads();
}

__device__ __forceinline__ void ml_post(Frame& F) {
    const int gw = F.vcu * NWAVES + F.wave, NGW = F.G * NWAVES;
    for (int it0 = gw; it0 < M * MLH; it0 += 4 * NGW) {
        f32x4 a[4], b[4]; float dn[4]; v4u ow[4];
#pragma unroll
        for (int k = 0; k < 4; ++k) { int it = it0 + k * NGW; it = it < M * MLH ? it : it0; const int row = it >> 2, h = it & 3;
            const float* np = A_WS(float, WS_NUM) + (size_t)row * 2048 + h * MLV + 8 * F.lane; a[k] = *(const f32x4*)np; b[k] = *(const f32x4*)(np + 4);
            dn[k] = A_WS(float, WS_DEN)[(size_t)row * MLH + h]; ow[k] = *(const v4u*)(A_WS(bf16, WS_MO) + (size_t)row * 2048 + h * MLV + 8 * F.lane); }
#pragma unroll
        for (int k = 0; k < 4; ++k) { const int it = it0 + k * NGW; if (it >= M * MLH) continue; const int row = it >> 2, h = it & 3;
            const float dinv = 1.0f / dn[k];
            float hv[8] = {a[k][0] * dinv, a[k][1] * dinv, a[k][2] * dinv, a[k][3] * dinv, b[k][0] * dinv, b[k][1] * dinv, b[k][2] * dinv, b[k][3] * dinv};
            float ss = 0.f;
#pragma unroll
            for (int e = 0; e < 8; ++e) ss += hv[e] * hv[e];
            ss = wave_sum(ss);
            const float rinv = rsqrtf(ss * (1.0f / MLV) + EPS);
            const float* gp = A_IN(17) + h * MLV + 8 * F.lane; const f32x4 g0 = *(const f32x4*)gp, g1 = *(const f32x4*)(gp + 4);
            const float ov[8] = {bf_lo(ow[k].x), bf_hi(ow[k].x), bf_lo(ow[k].y), bf_hi(ow[k].y), bf_lo(ow[k].z), bf_hi(ow[k].z), bf_lo(ow[k].w), bf_hi(ow[k].w)};
            const float gv[8] = {g0[0], g0[1], g0[2], g0[3], g1[0], g1[1], g1[2], g1[3]};
            float y[8];
#pragma unroll
            for (int e = 0; e < 8; ++e) y[e] = hv[e] * rinv * gv[e] / (1.0f + __expf(-ov[e]));
            v4u wv; wv.x = cvtpk(y[0], y[1]); wv.y = cvtpk(y[2], y[3]); wv.z = cvtpk(y[4], y[5]); wv.w = cvtpk(y[6], y[7]);
            *(v4u*)(A_WS(bf16, WS_MIX) + (size_t)row * LDX + 2048 + h * MLV + 8 * F.lane) = wv; } }
}
__device__ __forceinline__ void final_norm(Frame& F) {
    const int gw = F.vcu * NWAVES + F.wave, NGW = F.G * NWAVES;
    for (int row = gw; row < M; row += NGW) { const float rs = pg8::rs_of(A_SSQ(4), row); const v4u* xr = (const v4u*)(A_WS(bf16, WS_XB) + (size_t)row * D) + F.lane; f32x4* yr = (f32x4*)(A_XF + (size_t)row * D) + 2 * F.lane; const f32x4* gr = (const f32x4*)A_IN(26) + 2 * F.lane;
#pragma unroll
        for (int j = 0; j < 8; ++j) { const v4u v = xr[64 * j]; const f32x4 g0 = gr[128 * j], g1 = gr[128 * j + 1];
            __builtin_nontemporal_store((f32x4){bf_lo(v.x), bf_hi(v.x), bf_lo(v.y), bf_hi(v.y)} * rs * g0, yr + 128 * j); __builtin_nontemporal_store((f32x4){bf_lo(v.z), bf_hi(v.z), bf_lo(v.w), bf_hi(v.w)} * rs * g1, yr + 128 * j + 1); } }
}

__global__ void __launch_bounds__(NWAVES * 64, 2) hsm_fwd(Args args) {
    extern __shared__ __attribute__((aligned(16))) unsigned char lds[];
    Frame F;
    F.lds = (LAS unsigned char*)lds; F.MISC = (volatile LAS unsigned*)(F.lds + MISC_OFF);
    F.tid = threadIdx.x; F.lane = F.tid & 63; F.wave = __builtin_amdgcn_readfirstlane(F.tid >> 6);
    F.G = gridDim.x; { const int bx = blockIdx.x; F.vcu = (F.G % 8 == 0) ? (bx % 8) * (F.G / 8) + bx / 8 : bx; }
    unsigned char* ws = args.ws; F.a = &args;
    for (int u = F.tid; u < 64; u += NWAVES * 64) ((LAS unsigned*)(F.lds + MISC_OFF))[u] = 0u;
    __syncthreads();
    XcdBarrier bar; bar.bar = (unsigned*)(ws + CTL_BAR_BYTE); bar.x = 0; bar.st = nullptr;
    if (MK_N_LAUNCHES == 1) bar = xcd_barrier_post((unsigned*)(ws + CTL_BAR_BYTE), F.MISC + 8);
    const int lo = args.ph_lo, hi = args.ph_hi;
#ifndef PH_MASK
#define PH_MASK 0x7ff
#endif
#define IN(k) (((PH_MASK >> (k)) & 1) && lo <= (k) && (k) < hi)
#define SEAM(k) do { if (IN(k) && IN((k) + 1)) xcd_barrier(bar); } while (0)
    const int bx = (int)blockIdx.x;

    if (IN(0)) { p0_prologue(F); } SEAM(0);
    if (IN(1)) {
        { pg8::Gemm g{A_WS(bf16, WS_XB), A_WS(bf16, WS_W1GU), M, NGU, D, LDX}; pg8::SplitOrder S; S.init(M, NGU, D, F.G, bx, F.a->ws + WS_SLAB, (unsigned*)(F.a->ws + CTL_CNT_BYTE) + 0 * 512 * 32); pg8::EpiGateUp<false, false> E{F.a->ws, WS_HB, 0}; pg8::gemm_phase<pg8::EpiGateUp<false, false>, pg8::SplitOrder, true, true>(F.lds, g, S, E); }
    } SEAM(1);
    if (IN(2)) { pg8::Gemm g{A_WS(bf16, WS_HB), A_WS(bf16, WS_W1D), M, D, FFN, LDH}; pg8::SplitOrder S; S.init(M, D, FFN, F.G, bx, F.a->ws + WS_SLAB, (unsigned*)(F.a->ws + CTL_CNT_BYTE) + 1 * 512 * 32); pg8::EpiResid<false, true> E{nullptr, nullptr, F.a->ws, 0.5f, 1};
        pg8::gemm_phase<pg8::EpiResid<false, true>, pg8::SplitOrder, true, true>(F.lds, g, S, E); } SEAM(2);
    if (IN(3)) { gates_rows(F);
        pg8::Gemm g{A_WS(bf16, WS_XB), A_WS(bf16, WS_WIN), M, NIN, D, LDX}; pg8::SplitOrder S; S.init(M, NIN, D, F.G, bx, F.a->ws + WS_SLAB, (unsigned*)(F.a->ws + CTL_CNT_BYTE) + 2 * 512 * 32);
        pg8::EpiWin E{F.a->ws, A_OUT};
        pg8::gemm_phase<pg8::EpiWin, pg8::SplitOrder, true, true>(F.lds, g, S, E); } SEAM(3);
    if (IN(4)) {
        if (bx < 72) { const bool dn = bx >= 64; const int sh = dn ? bx - 64 : (bx & 7);
            mlstm_scan(F, sh >> 2, sh & 3, dn ? 0 : (bx >> 3), false, !dn, dn); }
        else { const int j = bx - 72, nb = F.G - 72;
            { pg8::Gemm g{A_WS(bf16, WS_PB), A_WS(bf16, WS_WPP), M, D, PLE, PLE}; pg8::SplitOrder S; S.init(M, D, PLE, nb, j, F.a->ws + WS_SLAB, (unsigned*)(F.a->ws + CTL_CNT_BYTE) + 3 * 512 * 32); pg8::EpiPlain E{A_WS(bf16, WS_PP), D}; pg8::gemm_phase<pg8::EpiPlain, pg8::SplitOrder, true, true>(F.lds, g, S, E); }
            __syncthreads();
            for (int su = j; su < DBATCH * MLH * 8; su += nb) mlstm_scan(F, su >> 5, (su >> 3) & 3, su & 7, true, true, (su & 7) == 0);
            const int nw = nb * NWAVES;
            __syncthreads();
            if (F.wave < 4) { for (int u = j * NWAVES + F.wave; u < (M / 16) * SBH; u += nw) sb_unit(F, u, F.lds + F.wave * SB_VBYTES); p0_late_weights(F, j * NWAVES + F.wave, nw); p0_ple_weights(F, j * NWAVES + F.wave, nw); }
            else { p0_late_weights(F, j * NWAVES + F.wave, nw); p0_ple_weights(F, j * NWAVES + F.wave, nw); for (int u = j * NWAVES + F.wave; u < (M / 16) * SBH; u += nw) sb_unit(F, u, F.lds + F.wave * SB_VBYTES); } }
    } SEAM(4);
    if (IN(5)) { ml_post(F); } SEAM(5);
    if (IN(6)) { pg8::Gemm g{A_WS(bf16, WS_MIX), A_WS(bf16, WS_WOUT), M, D, D, LDX}; pg8::SplitOrder S; S.init(M, D, D, F.G, bx, F.a->ws + WS_SLAB, (unsigned*)(F.a->ws + CTL_CNT_BYTE) + 4 * 512 * 32); pg8::EpiResid<true, true> E{nullptr, nullptr, F.a->ws, 1.0f, 2};
        pg8::gemm_phase<pg8::EpiResid<true, true>, pg8::SplitOrder, true, true>(F.lds, g, S, E); } SEAM(6);
    if (IN(7)) { pg8::Gemm g{A_WS(bf16, WS_XB8), A_WS(bf16, WS_W2GU), M, NGU, D / 2, D / 2}; pg8::SplitOrder S; S.init(M, NGU, D / 2, F.G, bx, F.a->ws + WS_SLAB, (unsigned*)(F.a->ws + CTL_CNT_BYTE) + 5 * 512 * 32); pg8::EpiGateUp<true, true> E{F.a->ws, WS_HB, 2};
        pg8::gemm_phase<pg8::EpiGateUp<true, true>, pg8::SplitOrder, true, true, true>(F.lds, g, S, E); } SEAM(7);
    if (IN(8)) { pg8::Gemm g{A_WS(bf16, WS_HB), A_WS(bf16, WS_W2D), M, D, FFN / 2, FFN / 2}; pg8::SplitOrder S; S.init(M, D, FFN / 2, F.G, bx, F.a->ws + WS_SLAB, (unsigned*)(F.a->ws + CTL_CNT_BYTE) + 6 * 512 * 32); pg8::EpiResid<true, true> E{nullptr, nullptr, F.a->ws, 0.5f / 64.f, 3};
        pg8::gemm_phase<pg8::EpiResid<true, true>, pg8::SplitOrder, true, true, true>(F.lds, g, S, E); } SEAM(8);
    if (IN(9)) { pg8::Gemm g{A_WS(bf16, WS_XB8), A_WS(bf16, WS_WPG), M, D, D / 2, D / 2}; pg8::SplitOrder S; S.init(M, D, D / 2, F.G, bx, F.a->ws + WS_SLAB, (unsigned*)(F.a->ws + CTL_CNT_BYTE) + 7 * 512 * 32); pg8::EpiPle E{F.a->ws, 1.0f / 64.f};
        pg8::gemm_phase<pg8::EpiPle, pg8::SplitOrder, true, true, true>(F.lds, g, S, E); } SEAM(9);
    if (IN(10)) { final_norm(F); }
#undef IN
#undef SEAM
}

extern "C" void kernel_launch(void* const* d_in, const int* in_sizes, int n_in, void* d_out, int out_size, void* d_ws, size_t ws_size, hipStream_t stream) {
    static int grid = 0;
    if (grid == 0) {
        if (n_in != 27 || out_size != (int)OUT_END || ws_size < WS_END) { fprintf(stderr, "kernel_launch: unexpected shapes (n_in %d, out %d, ws %zu; need ws >= %zu)\n", n_in, out_size, ws_size, (size_t)WS_END); grid = -1; return; }
        int dev = 0, cus = 0, per_cu = 0;
        if (hipGetDevice(&dev) != hipSuccess || hipDeviceGetAttribute(&cus, hipDeviceAttributeMultiprocessorCount, dev) != hipSuccess) { grid = -1; return; }
        if (hipFuncSetAttribute((const void*)hsm_fwd, hipFuncAttributeMaxDynamicSharedMemorySize, LDS_BYTES) != hipSuccess) { fprintf(stderr, "kernel_launch: hipFuncSetAttribute failed\n"); grid = -1; return; }
        if (hipOccupancyMaxActiveBlocksPerMultiprocessor(&per_cu, (const void*)hsm_fwd, NWAVES * 64, LDS_BYTES) != hipSuccess || per_cu < 1) fprintf(stderr, "kernel_launch: occupancy query says %d\n", per_cu);
        (void)hipGetLastError();
        grid = cus;
    }
    if (grid < 0) return;
    if (hipMemsetAsync((char*)d_ws + WS_CTL, 0, CTL_ZERO_BYTES, stream) != hipSuccess) return;
    Args a{};
    for (int i = 0; i < 27; ++i) a.in[i] = (const float*)d_in[i];
    a.out = (float*)d_out; a.ws = (unsigned char*)d_ws;
#if MK_N_LAUNCHES == 1
    a.ph_lo = 0; a.ph_hi = N_PHASES;
    hipLaunchKernelGGL(hsm_fwd, dim3(grid), dim3(NWAVES * 64), LDS_BYTES, stream, a);
#else
    for (int p = 0; p < N_PHASES; ++p) { a.ph_lo = p; a.ph_hi = p + 1; hipLaunchKernelGGL(hsm_fwd, dim3(grid), dim3(NWAVES * 64), LDS_BYTES, stream, a); }
#endif
}
```

```cpp
#include <hip/hip_runtime.h>
#include <cstdio>
#include <cstdint>

constexpr int NWAVES = 8;
constexpr int D = 4096, MP = 8192, MS = 256, M = MP + MS, FFN = 11008, NGU = 2 * FFN, NIN = 12288, NINF = 12296;
constexpr int SBW = 2048, SBH = 16, SBD = 128, MLH = 4, MLQK = 256, MLV = 512, PLE = 256, SEQ = 4096, PAST = 4096, DSEQ = 32, DBATCH = 8, CHUNK = 64;
constexpr float EPS = 1e-6f;
constexpr int LDX = D, LDH = FFN;
#ifndef MK_N_LAUNCHES
#define MK_N_LAUNCHES 1
#endif
constexpr int N_PHASES = 11;
constexpr size_t OUT_Y = 0, OUT_SBK_P = (size_t)M * D, OUT_SBV_P = OUT_SBK_P + (size_t)MP * SBW, OUT_MLC_P = OUT_SBV_P + (size_t)MP * SBW, OUT_MLN_P = OUT_MLC_P + (size_t)2 * MLH * MLV * MLQK,
    OUT_MLM_P = OUT_MLN_P + 2 * MLH * MLQK, OUT_SBK_S = OUT_MLM_P + 2 * MLH, OUT_SBV_S = OUT_SBK_S + (size_t)MS * SBW, OUT_MLC_S = OUT_SBV_S + (size_t)MS * SBW,
    OUT_MLN_S = OUT_MLC_S + (size_t)DBATCH * MLH * MLV * MLQK, OUT_MLM_S = OUT_MLN_S + DBATCH * MLH * MLQK, OUT_END = OUT_MLM_S + DBATCH * MLH;
static_assert(OUT_END == 74459176, "output size");
constexpr size_t MiB = 1u << 20;
constexpr size_t al(size_t x) { return (x + MiB - 1) / MiB * MiB; }
constexpr size_t WS_CTL = 0, CTL_ZERO_BYTES = 2 * MiB;
constexpr size_t CTL_BAR_BYTE = 16384;
constexpr size_t CTL_SSQ_BYTE = 65536;
constexpr size_t WS_W1GU = 2 * MiB, WS_W1D = WS_W1GU + al((size_t)NGU * LDX * 2), WS_WIN = WS_W1D + al((size_t)D * LDH * 2), WS_WOUT = WS_WIN + al((size_t)NIN * LDX * 2),
    WS_W2GU = WS_WOUT + al((size_t)D * LDX * 2), WS_W2D = WS_W2GU + al((size_t)NGU * LDX * 2), WS_WPG = WS_W2D + al((size_t)D * LDH * 2), WS_WPP = WS_WPG + al((size_t)D * LDX * 2),
    WS_WIF = WS_WPP + al((size_t)D * PLE * 2), WS_XB = WS_WIF + al((size_t)8 * D * 4), WS_HB = WS_XB + al((size_t)M * LDX * 2), WS_QB = WS_HB + al((size_t)M * LDH * 2),
    WS_KB = WS_QB + al((size_t)M * SBW * 2), WS_VB = WS_KB + al((size_t)M * SBW * 2), WS_MQ = WS_VB + al((size_t)M * SBW * 2), WS_MK = WS_MQ + al((size_t)M * 1024 * 2),
    WS_MV = WS_MK + al((size_t)M * 1024 * 2), WS_MO = WS_MV + al((size_t)M * 2048 * 2), WS_GATES = WS_MO + al((size_t)M * 2048 * 2), WS_MIX = WS_GATES + al((size_t)M * 8 * 4),
    WS_PP = WS_MIX + al((size_t)M * LDX * 2), WS_PB = WS_PP + al((size_t)M * D * 2), WS_NUM = WS_PB + al((size_t)M * PLE * 2), WS_DEN = WS_NUM + al((size_t)M * 2048 * 4),
    WS_MLS = WS_DEN + al((size_t)M * 4 * 4), WS_XB8 = WS_MLS + al((size_t)256 * 21504 * 4)  , WS_SLAB = WS_XB8 + al((size_t)M * D)  , WS_END = WS_SLAB + (size_t)256 * 262144;
constexpr size_t CTL_CNT_BYTE = 1 * MiB;
static_assert(CTL_SSQ_BYTE + 6 * (size_t)M * 8 <= CTL_CNT_BYTE && CTL_CNT_BYTE + 8 * 512 * 128 <= CTL_ZERO_BYTES, "ctl");
constexpr int LDS_BYTES = 163840;
constexpr int MISC_OFF = 163840 - 256;

namespace pg8 {
#define PG8_LAS __attribute__((address_space(3)))
typedef unsigned short bf16_t;
typedef short bf16x8 __attribute__((ext_vector_type(8)));
typedef float f32x4 __attribute__((ext_vector_type(4)));
typedef unsigned u32x4 __attribute__((ext_vector_type(4)));
typedef int v8i __attribute__((ext_vector_type(8)));
constexpr int BM = 256, BK = 64, HALF = 128, HTB = HALF * BK * 2  , STAGE_BYTES = 8 * HTB, NXCD = 8, WGM = 8;

__host__ __device__ __forceinline__ int lds_byte(int r, int c) { const int st = (r >> 4) * 2 + (c >> 5), rr = r & 15, cc = c & 31, ob = rr * 64 + cc * 2; return st * 1024 + (ob ^ (((ob >> 9) & 1) << 5)); }
__host__ __device__ __forceinline__ void stage_rc(int b, int& R, int& C) { const int st = b / 1024, sb = b % 1024, swz = sb ^ (((sb >> 9) & 1) << 5); R = (st >> 1) * 16 + swz / 64; C = (st & 1) * 32 + (swz % 64) / 2; }
__host__ __device__ __forceinline__ int perm32(int rho) { const int n = rho >> 4, i = rho & 15; return 8 * (i >> 2) + 4 * n + (i & 3); }

struct Unit { int pm, pn, k0, nk, split, S, s, tile, xw, rx, ix; };
constexpr int SLAB_BYTES = 256 * 256 * 4;
struct Gemm { const bf16_t* A; const bf16_t* Bt; int M, N, K, ld; };

struct StaticOrder {
    int nM, nN, nwg, G, c;
    __host__ __device__ void init(int M, int N, int G_, int c_) { nM = M / BM; nN = N / BM; nwg = nM * nN; G = G_; c = c_; }
    __host__ __device__ bool next(int i, Unit& u) const {
        const long L = (long)i * G + c; if (L >= nwg) return false;
        int wgid = (int)L; { const int q = nwg / NXCD, r = nwg % NXCD, xcd = wgid % NXCD, off = wgid / NXCD; wgid = (xcd < r ? xcd * (q + 1) : r * (q + 1) + (xcd - r) * q) + off; }
        const int nig = WGM * nN, gid = wgid / nig, fm = gid * WGM, gsz = (nM - fm) < WGM ? (nM - fm) : WGM;
        u.pm = fm + ((wgid % nig) % gsz); u.pn = (wgid % nig) / gsz; return true;
    }
    __device__ __forceinline__ void a_ready(const Unit&) const {}
    __device__ __forceinline__ void done(const Unit&) const {}
};
typedef float f32x2_t __attribute__((ext_vector_type(2)));
typedef __bf16 bf16x2_t __attribute__((ext_vector_type(2)));
typedef unsigned u32x2 __attribute__((ext_vector_type(2)));
__device__ __forceinline__ unsigned cvtpk(float lo, float hi) { f32x2_t v = {lo, hi}; bf16x2_t b = __builtin_convertvector(v, bf16x2_t); return __builtin_bit_cast(unsigned, b); }
template <class T> __device__ __forceinline__ T* opq(T* p) { const unsigned long long v = (unsigned long long)p; unsigned lo = __builtin_amdgcn_readfirstlane((unsigned)v), hi = __builtin_amdgcn_readfirstlane((unsigned)(v >> 32));
    asm volatile("" : "+s"(lo), "+s"(hi)); return (T*)(((unsigned long long)hi << 32) | lo); }
__device__ __forceinline__ float opqf(float x) { unsigned v = __builtin_amdgcn_readfirstlane(__float_as_uint(x)); asm volatile("" : "+s"(v)); return __uint_as_float(v); }
constexpr int DM = 4096, DFF = 11008, MPROMPT = 8192;
constexpr float SSQ_SCALE = 16777216.0f;
__device__ __forceinline__ float rs_of(const unsigned long long* ssq, int row) { return rsqrtf((float)ssq[row] * (1.0f / (16777216.0f * 4096.0f)) + 1e-6f); }
__device__ __forceinline__ unsigned pack4_fp8(float a, float b, float c, float d) { int w = __builtin_amdgcn_cvt_pk_fp8_f32(a, b, 0, false); w = __builtin_amdgcn_cvt_pk_fp8_f32(c, d, w, true); return (unsigned)w; }
__device__ __forceinline__ unsigned long long ssq_fix(float s) { return (unsigned long long)(s * SSQ_SCALE + 0.5f); }


struct SplitOrder {
    int nM, nN, nwg, G, c, ntk, Rf, r, split_ok; unsigned char* slab; unsigned* cnt;
    __device__ __forceinline__ void init(int M, int N, int K, int G_, int c_, unsigned char* slab_, unsigned* cnt_) { nM = M / BM; nN = N / BM; nwg = nM * nN; G = __builtin_amdgcn_readfirstlane(G_); c = __builtin_amdgcn_readfirstlane(c_); ntk = K / BK;
        Rf = __builtin_amdgcn_readfirstlane(nwg / G); r = nwg - Rf * G; slab = slab_; cnt = cnt_; split_ok = (G % 8 == 0) && (G >= 64) && (ntk >= 8) && (ntk % 2 == 0); }
    __device__ __forceinline__ void map(int L, Unit& u) const {
        int wgid = L; { const int q = nwg / NXCD, r8 = nwg % NXCD, xcd = wgid % NXCD, off = wgid / NXCD; wgid = (xcd < r8 ? xcd * (q + 1) : r8 * (q + 1) + (xcd - r8) * q) + off; }
        const int nig = WGM * nN, gid = wgid / nig, fm = gid * WGM, gsz = (nM - fm) < WGM ? (nM - fm) : WGM;
        u.pm = __builtin_amdgcn_readfirstlane(fm + ((wgid % nig) % gsz)); u.pn = __builtin_amdgcn_readfirstlane((wgid % nig) / gsz); }
    __device__ __forceinline__ bool next(int i, Unit& u) const {
        u.k0 = 0; u.nk = ntk; u.split = 0; u.S = 1; u.s = 0; u.tile = 0; u.xw = 0; u.rx = 1; u.ix = i;
        if (i < Rf) { map(i * G + c, u); return true; }
        if (i > Rf || r == 0) return false;
        if (!split_ok) { if (c >= r) return false; map(Rf * G + c, u); return true; }
        const int x = c & 7, w = c >> 3, W = G >> 3, rx = (x < r) ? (r - x + 7) / 8 : 0;
        if (rx == 0) return false;
        const int s = __builtin_amdgcn_readfirstlane(w / rx), tp = w - s * rx; int S = __builtin_amdgcn_readfirstlane((W - tp + rx - 1) / rx); const int np = ntk / 2; if (S > np / 2) S = np / 2;
        if (s >= S) return false;
        const int j = x + 8 * tp; map(Rf * G + j, u);
        const int p0 = __builtin_amdgcn_readfirstlane((s * np) / S), p1 = __builtin_amdgcn_readfirstlane(((s + 1) * np) / S);
        u.k0 = 2 * p0; u.nk = 2 * (p1 - p0); u.split = (S > 1) ? 1 : 0; u.S = S; u.s = s; u.tile = j; u.xw = x + 8 * tp; u.rx = rx; return true; }
    __device__ __forceinline__ void a_ready(const Unit&) const {}
    __device__ __forceinline__ void done(const Unit&) const {}
};

#define PG8_RSC(u_, r_) (((const PG8_LAS float*)(unsigned)131072u)[(u_).ix * 256 + (r_)])
template <bool W8, bool H8> struct EpiGateUp {
    static constexpr bool PERM = false, AFTER_DRAIN = false, RSC = true;
    __device__ __forceinline__ const unsigned long long* rs_src() const { return (const unsigned long long*)(ws + CTL_SSQ_BYTE) + (size_t)ssq_k * 8448; }
    unsigned char* ws; size_t h_off; int ssq_k;
    __device__ __forceinline__ void operator()(const f32x4 (&acc)[2][2][4][2], const Unit& u, int wr, int wc, int fr, int fq, unsigned mask) const {
        const int row0 = u.pm * BM + wr * 64 + fr, col0 = u.pn * 128 + wc * 16 + 4 * fq; unsigned char* const wsp = opq(this->ws); bf16_t* const H = (bf16_t*)(wsp + h_off); const unsigned long long* const ssq = (const unsigned long long*)(wsp + CTL_SSQ_BYTE) + (size_t)ssq_k * 8448;
#pragma unroll
        for (int ai = 0; ai < 2; ++ai)
#pragma unroll
            for (int m = 0; m < 4; ++m) { if (!((mask >> ((ai * 4 + m) * 2)) & 3u)) continue; const int row = row0 + ai * HALF + m * 16; const float rs = PG8_RSC(u, wr * 64 + fr + ai * HALF + m * 16) * (W8 ? 0.015625f : 1.0f); bf16_t* rowp = H + (size_t)row * LDH + col0;
#pragma unroll
                for (int bj = 0; bj < 2; ++bj) { if (!((mask >> ((ai * 4 + m) * 2 + bj)) & 1u)) continue; const f32x4 g = acc[ai][bj][m][0] * rs, up = acc[ai][bj][m][1] * rs; f32x4 h;
#pragma unroll
                    for (int e = 0; e < 4; ++e) h[e] = g[e] * __builtin_amdgcn_rcpf(1.0f + __expf(-g[e])) * up[e];
                    if constexpr (H8) *(unsigned*)((unsigned char*)H + (size_t)row * DFF + col0 + bj * 64) = pack4_fp8(h[0], h[1], h[2], h[3]);
                    else { u32x2 w; w.x = cvtpk(h[0], h[1]); w.y = cvtpk(h[2], h[3]); *(u32x2*)(rowp + bj * 64) = w; } } }
    }
};
template <bool OUT8, bool RESB> struct EpiResid {
    static constexpr bool PERM = true, AFTER_DRAIN = false, RSC = false;
    const float* res_p; const float* res_s; unsigned char* ws; float alpha; int ssq_k;
    __device__ __forceinline__ void operator()(const f32x4 (&acc)[2][2][4][2], const Unit& u, int wr, int wc, int fr, int fq, unsigned mask) const {
        const int row0 = u.pm * BM + wr * 64 + fr, col0 = u.pn * BM + wc * 32 + 8 * fq;
        const float* src = RESB ? nullptr : opq((u.pm < 32) ? res_p : (res_s - (size_t)MPROMPT * DM)); unsigned char* const wsp = opq(this->ws); bf16_t* const XB = (bf16_t*)(wsp + WS_XB); unsigned long long* const ssq_out = (unsigned long long*)(wsp + CTL_SSQ_BYTE) + (size_t)ssq_k * 8448; const float alpha = opqf(this->alpha);
#pragma unroll
        for (int ai = 0; ai < 2; ++ai)
#pragma unroll
            for (int m = 0; m < 4; ++m) { if (!((mask >> ((ai * 4 + m) * 2)) & 3u)) continue; const int row = row0 + ai * HALF + m * 16; const size_t off = (size_t)row * DM + col0; float ss = 0.f;
#pragma unroll
                for (int bj = 0; bj < 2; ++bj) { if (!((mask >> ((ai * 4 + m) * 2 + bj)) & 1u)) continue; bf16_t* const xb = XB + (size_t)row * LDX + col0 + bj * HALF; f32x4 r0, r1;
                    if constexpr (RESB) { const u32x4 rw = *(const u32x4*)xb; r0[0] = __uint_as_float(rw.x << 16); r0[1] = __uint_as_float(rw.x & 0xffff0000u); r0[2] = __uint_as_float(rw.y << 16); r0[3] = __uint_as_float(rw.y & 0xffff0000u);
                        r1[0] = __uint_as_float(rw.z << 16); r1[1] = __uint_as_float(rw.z & 0xffff0000u); r1[2] = __uint_as_float(rw.w << 16); r1[3] = __uint_as_float(rw.w & 0xffff0000u); }
                    else { r0 = *(const f32x4*)(src + off + bj * HALF); r1 = *(const f32x4*)(src + off + bj * HALF + 4); }
                    const f32x4 o0 = r0 + acc[ai][bj][m][0] * alpha, o1 = r1 + acc[ai][bj][m][1] * alpha;
                    { u32x4 w; w.x = cvtpk(o0[0], o0[1]); w.y = cvtpk(o0[2], o0[3]); w.z = cvtpk(o1[0], o1[1]); w.w = cvtpk(o1[2], o1[3]); *(u32x4*)xb = w; }
                    if constexpr (OUT8) { u32x2 q; q.x = pack4_fp8(o0[0], o0[1], o0[2], o0[3]); q.y = pack4_fp8(o1[0], o1[1], o1[2], o1[3]); *(u32x2*)(wsp + WS_XB8 + (size_t)row * DM + col0 + bj * HALF) = q; }
                    ss += ((o0[0] * o0[0] + o0[1] * o0[1]) + (o0[2] * o0[2] + o0[3] * o0[3])) + ((o1[0] * o1[0] + o1[1] * o1[1]) + (o1[2] * o1[2] + o1[3] * o1[3])); }
                ss += __shfl_xor(ss, 16); ss += __shfl_xor(ss, 32);
                if (fq == 0) atomicAdd(ssq_out + row, ssq_fix(ss));
                if (m == 3) asm volatile("" ::: "memory"); }
    }
};
struct EpiPle {
    static constexpr bool PERM = true, AFTER_DRAIN = false, RSC = true;
    __device__ __forceinline__ const unsigned long long* rs_src() const { return (const unsigned long long*)(ws + CTL_SSQ_BYTE) + (size_t)3 * 8448; }
    unsigned char* ws; float zscale;
    __device__ __forceinline__ void operator()(const f32x4 (&acc)[2][2][4][2], const Unit& u, int wr, int wc, int fr, int fq, unsigned mask) const {
        const int row0 = u.pm * BM + wr * 64 + fr, col0 = u.pn * BM + wc * 32 + 8 * fq;
        unsigned char* const wsp = opq(this->ws); const float zscale = opqf(this->zscale); const bf16_t* const PP = (const bf16_t*)(wsp + WS_PP); bf16_t* const XB = (bf16_t*)(wsp + WS_XB); const unsigned long long* const ssq = (const unsigned long long*)(wsp + CTL_SSQ_BYTE) + (size_t)3 * 8448; unsigned long long* const ssq_out = (unsigned long long*)(wsp + CTL_SSQ_BYTE) + (size_t)4 * 8448;
#pragma unroll
        for (int ai = 0; ai < 2; ++ai)
#pragma unroll
            for (int m = 0; m < 4; ++m) { if (!((mask >> ((ai * 4 + m) * 2)) & 3u)) continue; const int row = row0 + ai * HALF + m * 16; const size_t off = (size_t)row * DM + col0; const float rs = PG8_RSC(u, wr * 64 + fr + ai * HALF + m * 16) * zscale; float ss = 0.f;
#pragma unroll
                for (int bj = 0; bj < 2; ++bj) { if (!((mask >> ((ai * 4 + m) * 2 + bj)) & 1u)) continue; bf16_t* const xb = XB + (size_t)row * LDX + col0 + bj * HALF;
                    const u32x4 xw = *(const u32x4*)xb; const u32x4 pw = *(const u32x4*)(PP + off + bj * HALF);
                    const unsigned xs[4] = {xw.x, xw.y, xw.z, xw.w}, ps[4] = {pw.x, pw.y, pw.z, pw.w}; unsigned ow[4];
#pragma unroll
                    for (int n = 0; n < 2; ++n) { const f32x4 z = acc[ai][bj][m][n] * rs;
#pragma unroll
                        for (int hh = 0; hh < 2; ++hh) { const unsigned xv = xs[2 * n + hh], pv = ps[2 * n + hh];
                            const float oa = __uint_as_float(xv << 16) + __builtin_amdgcn_rcpf(1.0f + __expf(-z[2 * hh])) * __uint_as_float(pv << 16);
                            const float ob = __uint_as_float(xv & 0xffff0000u) + __builtin_amdgcn_rcpf(1.0f + __expf(-z[2 * hh + 1])) * __uint_as_float(pv & 0xffff0000u);
                            ow[2 * n + hh] = cvtpk(oa, ob); ss += oa * oa + ob * ob; } }
                    { u32x4 w; w.x = ow[0]; w.y = ow[1]; w.z = ow[2]; w.w = ow[3]; *(u32x4*)xb = w; } }
                ss += __shfl_xor(ss, 16); ss += __shfl_xor(ss, 32);
                if (fq == 0) atomicAdd(ssq_out + row, ssq_fix(ss));
                if (m == 3) asm volatile("" ::: "memory"); }
    }
};
struct EpiPlain {
    static constexpr bool PERM = false, AFTER_DRAIN = false, RSC = false;
    bf16_t* O; int ldc;
    __device__ __forceinline__ void operator()(const f32x4 (&acc)[2][2][4][2], const Unit& u, int wr, int wc, int fr, int fq, unsigned mask) const {
        const int row0 = u.pm * BM + wr * 64 + fr, col0 = u.pn * BM + wc * 32 + 4 * fq;
#pragma unroll
        for (int ai = 0; ai < 2; ++ai)
#pragma unroll
            for (int m = 0; m < 4; ++m) { if (!((mask >> ((ai * 4 + m) * 2)) & 3u)) continue; bf16_t* rowp = opq(O) + (size_t)(row0 + ai * HALF + m * 16) * ldc + col0;
#pragma unroll
                for (int bj = 0; bj < 2; ++bj)
#pragma unroll
                    for (int n = 0; n < 2; ++n) { if (!((mask >> ((ai * 4 + m) * 2 + bj)) & 1u)) continue; const f32x4 v = acc[ai][bj][m][n]; u32x2 w; w.x = cvtpk(v[0], v[1]); w.y = cvtpk(v[2], v[3]); *(u32x2*)(rowp + bj * HALF + n * 16) = w; } }
    }
};
struct EpiWin {
    static constexpr bool PERM = true, AFTER_DRAIN = false, RSC = true;
    __device__ __forceinline__ const unsigned long long* rs_src() const { return (const unsigned long long*)(ws + CTL_SSQ_BYTE) + (size_t)1 * 8448; }
    unsigned char* ws; float* out;
    __device__ __forceinline__ void operator()(const f32x4 (&acc)[2][2][4][2], const Unit& u, int wr, int wc, int fr, int fq, unsigned mask) const {
        const int row0 = u.pm * BM + wr * 64 + fr; const int pn = u.pn;
        bf16_t* dst; int ld, cbase; float sc = 1.f; float* fdst = nullptr;
        unsigned char* const wsp = opq(this->ws); float* const outp = opq(this->out); size_t doff;
        if (pn < 8) { doff = WS_QB; ld = 2048; cbase = pn * 256; sc = 0.08838834764831845f; }
        else if (pn < 16) { doff = WS_KB; ld = 2048; cbase = (pn - 8) * 256; fdst = (u.pm < 32) ? outp + OUT_SBK_P : (outp + OUT_SBK_S - (size_t)MPROMPT * 2048); }
        else if (pn < 24) { doff = WS_VB; ld = 2048; cbase = (pn - 16) * 256; fdst = (u.pm < 32) ? outp + OUT_SBV_P : (outp + OUT_SBV_S - (size_t)MPROMPT * 2048); }
        else if (pn < 28) { doff = WS_MQ; ld = 1024; cbase = (pn - 24) * 256; sc = 0.0625f; }
        else if (pn < 32) { doff = WS_MK; ld = 1024; cbase = (pn - 28) * 256; }
        else if (pn < 40) { doff = WS_MV; ld = 2048; cbase = (pn - 32) * 256; }
        else { doff = WS_MO; ld = 2048; cbase = (pn - 40) * 256; }
        dst = (bf16_t*)(wsp + doff);
        const int col0 = cbase + wc * 32 + 8 * fq; const unsigned long long* const ssq = (const unsigned long long*)(wsp + CTL_SSQ_BYTE) + (size_t)1 * 8448;
#pragma unroll
        for (int ai = 0; ai < 2; ++ai)
#pragma unroll
            for (int m = 0; m < 4; ++m) { if (!((mask >> ((ai * 4 + m) * 2)) & 3u)) continue; const int row = row0 + ai * HALF + m * 16; const float rs = PG8_RSC(u, wr * 64 + fr + ai * HALF + m * 16) * sc; bf16_t* rowp = dst + (size_t)row * ld + col0;
#pragma unroll
                for (int bj = 0; bj < 2; ++bj) { if (!((mask >> ((ai * 4 + m) * 2 + bj)) & 1u)) continue; const f32x4 v0 = acc[ai][bj][m][0] * rs, v1 = acc[ai][bj][m][1] * rs;
                    u32x4 w; w.x = cvtpk(v0[0], v0[1]); w.y = cvtpk(v0[2], v0[3]); w.z = cvtpk(v1[0], v1[1]); w.w = cvtpk(v1[2], v1[3]);
                    *(u32x4*)(rowp + bj * HALF) = w;
                    if (fdst) { float* fp = fdst + (size_t)row * 2048 + col0 + bj * HALF; __builtin_nontemporal_store(v0, (f32x4*)fp); __builtin_nontemporal_store(v1, (f32x4*)(fp + 4)); } } }
    }
};

template <class Epi, class Sched, bool ALIGN_EPI = false, bool SP2 = false, bool F8 = false>
__device__ __forceinline__ void gemm_phase(PG8_LAS unsigned char* lds, const Gemm g, const Sched& S, const Epi& E) {
    const int tid = threadIdx.x, wid = __builtin_amdgcn_readfirstlane(tid >> 6), lane = tid & 63, wr = wid >> 2, wc = wid & 3, fr = lane & 15, fq = lane >> 4;
    const int K = g.K;
    unsigned voffA[2], voffB[2];
#pragma unroll
    for (int i = 0; i < 2; ++i) { int R, C; stage_rc(tid * 16 + i * 8192, R, C); const int Rb = Epi::PERM ? ((R & ~31) + perm32(R & 31)) : R;
        voffA[i] = (unsigned)(R * g.ld + C) * 2u; voffB[i] = (unsigned)(Rb * g.ld + C) * 2u; }
    const size_t kstep = (size_t)(BK * 2);
    const size_t hstep = (size_t)HALF * g.ld * 2;
    const size_t tstep = 2 * hstep;
    const unsigned ldsw = (unsigned)wid * 1024u;
    const int aoff = lds_byte(wr * 64 + fr, fq * 8), boff = lds_byte(wc * 32 + fr, fq * 8);
    const int aoff8a = lds_byte(wr * 64 + fr, fq * 16), aoff8b = lds_byte(wr * 64 + fr, fq * 16 + 8), boff8a = lds_byte(wc * 32 + fr, fq * 16), boff8b = lds_byte(wc * 32 + fr, fq * 16 + 8);
#define PG8_SA(b, h) (((b) * 2 + (h)) * HTB)
#define PG8_SB(b, h) ((4 + (b) * 2 + (h)) * HTB)
#define PG8_STAGE(bufoff, gbase, voff) do { _Pragma("unroll") for (int _i = 0; _i < 2; ++_i) \
        __builtin_amdgcn_global_load_lds((const unsigned*)((const char*)(gbase) + (voff)[_i]), (PG8_LAS unsigned*)(lds + (bufoff) + ldsw + _i * 8192), 16, 0, 0); } while (0)
#define PG8_LDA(dst, b, h) do { if constexpr (F8) { _Pragma("unroll") for (int m = 0; m < 4; ++m) { const u32x4 lo_ = *(const PG8_LAS u32x4*)(lds + PG8_SA(b, h) + aoff8a + m * 2048), hi_ = *(const PG8_LAS u32x4*)(lds + PG8_SA(b, h) + aoff8b + m * 2048); \
            dst##8[m] = (v8i){(int)lo_.x, (int)lo_.y, (int)lo_.z, (int)lo_.w, (int)hi_.x, (int)hi_.y, (int)hi_.z, (int)hi_.w}; } } \
        else { _Pragma("unroll") for (int m = 0; m < 4; ++m) _Pragma("unroll") for (int k = 0; k < 2; ++k) dst[m][k] = *(const PG8_LAS bf16x8*)(lds + PG8_SA(b, h) + aoff + m * 2048 + k * 1024); } } while (0)
#define PG8_LDB(dst, b, h) do { if constexpr (F8) { _Pragma("unroll") for (int n = 0; n < 2; ++n) { const u32x4 lo_ = *(const PG8_LAS u32x4*)(lds + PG8_SB(b, h) + boff8a + n * 2048), hi_ = *(const PG8_LAS u32x4*)(lds + PG8_SB(b, h) + boff8b + n * 2048); \
            dst##8[n] = (v8i){(int)lo_.x, (int)lo_.y, (int)lo_.z, (int)lo_.w, (int)hi_.x, (int)hi_.y, (int)hi_.z, (int)hi_.w}; } } \
        else { _Pragma("unroll") for (int n = 0; n < 2; ++n) _Pragma("unroll") for (int k = 0; k < 2; ++k) dst[n][k] = *(const PG8_LAS bf16x8*)(lds + PG8_SB(b, h) + boff + n * 2048 + k * 1024); } } while (0)
#define PG8_MMA(ai, bj, At, Bt) do { __builtin_amdgcn_s_setprio(1); \
        if constexpr (F8) { _Pragma("unroll") for (int m = 0; m < 4; ++m) _Pragma("unroll") for (int n = 0; n < 2; ++n) \
            asm volatile("v_mfma_f32_16x16x128_f8f6f4 %0, %1, %2, %0" : "+v"(acc[ai][bj][m][n]) : "v"(Bt##8[n]), "v"(At##8[m])); } \
        else { _Pragma("unroll") for (int m = 0; m < 4; ++m) _Pragma("unroll") for (int n = 0; n < 2; ++n) _Pragma("unroll") for (int k = 0; k < 2; ++k) \
            acc[ai][bj][m][n] = __builtin_amdgcn_mfma_f32_16x16x32_bf16(Bt[n][k], At[m][k], acc[ai][bj][m][n], 0, 0, 0); } __builtin_amdgcn_s_setprio(0); } while (0)
#define PG8_WAIT_V(n) asm volatile("s_waitcnt vmcnt(" #n ")" ::: "memory")
#define PG8_WAIT_L(n) asm volatile("s_waitcnt lgkmcnt(" #n ")" ::: "memory")
#define PG8_BAR __builtin_amdgcn_s_barrier()
#define PG8_SCHED __builtin_amdgcn_sched_barrier(0)
    Unit cur, nxt; int ui = 0;
    if (!S.next(0, cur)) return;
    if constexpr (Epi::RSC) {
        if (tid < 256) { const unsigned long long* sp = E.rs_src(); unsigned long long raw[13];
#pragma unroll
            for (int i = 0; i < 13; ++i) { Unit t; const bool ok = S.next(i, t); raw[i] = sp[(ok ? t.pm : 0) * BM + tid]; }
#pragma unroll
            for (int i = 0; i < 13; ++i) ((PG8_LAS float*)(lds + 131072))[i * 256 + tid] = rsqrtf((float)raw[i] * (1.0f / (16777216.0f * 4096.0f)) + 1e-6f); } }
    f32x4 acc[2][2][4][2];
#pragma unroll
    for (int a = 0; a < 2; ++a)
#pragma unroll
        for (int b = 0; b < 2; ++b)
#pragma unroll
            for (int m = 0; m < 4; ++m)
#pragma unroll
                for (int n = 0; n < 2; ++n) acc[a][b][m][n] = (f32x4){0.f, 0.f, 0.f, 0.f};
    bf16x8 At[4][2], B0[2][2], B1[2][2]; v8i At8[4], B08[2], B18[2];
    int sc127 = 127; asm volatile("" : "+v"(sc127));
    const char* cA = (const char*)g.A + (size_t)cur.pm * tstep + (size_t)cur.k0 * kstep; const char* cB = (const char*)g.Bt + (size_t)cur.pn * tstep + (size_t)cur.k0 * kstep;
    S.a_ready(cur);
    if constexpr (SP2) {
        PG8_STAGE(PG8_SB(0, 0), cB, voffB); PG8_STAGE(PG8_SB(0, 1), cB + hstep, voffB); PG8_STAGE(PG8_SA(0, 0), cA, voffA); PG8_STAGE(PG8_SA(0, 1), cA + hstep, voffA);
        if (wr == 1) PG8_BAR;
        PG8_WAIT_V(2); PG8_BAR;
        PG8_STAGE(PG8_SB(1, 0), cB + kstep, voffB); PG8_STAGE(PG8_SA(1, 0), cA + kstep, voffA); PG8_STAGE(PG8_SB(1, 1), cB + hstep + kstep, voffB);
        PG8_WAIT_V(6); PG8_BAR;
    } else {
        PG8_STAGE(PG8_SB(0, 0), cB, voffB); PG8_STAGE(PG8_SA(0, 0), cA, voffA); PG8_STAGE(PG8_SB(0, 1), cB + hstep, voffB); PG8_STAGE(PG8_SA(0, 1), cA + hstep, voffA);
        if (wr == 1) PG8_BAR;
        PG8_WAIT_V(4); PG8_BAR;
        PG8_STAGE(PG8_SB(1, 0), cB + kstep, voffB); PG8_STAGE(PG8_SA(1, 0), cA + kstep, voffA); PG8_STAGE(PG8_SB(1, 1), cB + hstep + kstep, voffB);
        PG8_WAIT_V(6); PG8_BAR;
    }
    for (;;) {
        const bool has_next = S.next(ui + 1, nxt);
        const char* nA = has_next ? (const char*)g.A + (size_t)nxt.pm * tstep + (size_t)nxt.k0 * kstep : cA; const char* nB = has_next ? (const char*)g.Bt + (size_t)nxt.pn * tstep + (size_t)nxt.k0 * kstep : cB;
        const int nt = cur.nk;
        for (int t = 0; t < nt; t += 2) {
            const bool last = (t == nt - 2);
            const char* a1 = cA + (size_t)(t + 1) * kstep;
            const char* a2 = last ? nA : cA + (size_t)(t + 2) * kstep; const char* b2 = last ? nB : cB + (size_t)(t + 2) * kstep;
            const char* a3 = a2 + kstep; const char* b3 = b2 + kstep;
            if (last && has_next) S.a_ready(nxt);
            if constexpr (SP2) {
            PG8_LDB(B0, 0, 0); PG8_LDB(B1, 0, 1); PG8_SCHED; PG8_LDA(At, 0, 0); PG8_STAGE(PG8_SA(1, 1), a1 + hstep, voffA);
            PG8_WAIT_V(8); PG8_WAIT_L(0); PG8_BAR; PG8_MMA(0, 0, At, B0); PG8_MMA(0, 1, At, B1); PG8_BAR; PG8_SCHED;
            PG8_LDA(At, 0, 1); PG8_STAGE(PG8_SB(0, 0), b2, voffB); PG8_STAGE(PG8_SB(0, 1), b2 + hstep, voffB); PG8_STAGE(PG8_SA(0, 0), a2, voffA);
            PG8_WAIT_V(8); PG8_WAIT_L(0); PG8_BAR; PG8_MMA(1, 0, At, B0); PG8_MMA(1, 1, At, B1); PG8_BAR; PG8_SCHED;
            PG8_LDB(B0, 1, 0); PG8_LDB(B1, 1, 1); PG8_SCHED; PG8_LDA(At, 1, 0); PG8_STAGE(PG8_SA(0, 1), a2 + hstep, voffA);
            PG8_WAIT_V(8); PG8_WAIT_L(0); PG8_BAR; PG8_MMA(0, 0, At, B0); PG8_MMA(0, 1, At, B1); PG8_BAR; PG8_SCHED;
            PG8_LDA(At, 1, 1); PG8_STAGE(PG8_SB(1, 0), b3, voffB); PG8_STAGE(PG8_SB(1, 1), b3 + hstep, voffB); PG8_STAGE(PG8_SA(1, 0), a3, voffA);
            PG8_WAIT_V(8); PG8_WAIT_L(0); PG8_BAR; PG8_MMA(1, 0, At, B0); PG8_MMA(1, 1, At, B1); PG8_BAR; PG8_SCHED;
            } else {
            PG8_LDB(B0, 0, 0); PG8_SCHED; PG8_LDA(At, 0, 0); PG8_STAGE(PG8_SA(1, 1), a1 + hstep, voffA);
            PG8_WAIT_L(8); PG8_BAR; PG8_WAIT_L(0); PG8_MMA(0, 0, At, B0); PG8_BAR; PG8_SCHED;
            PG8_LDB(B1, 0, 1); PG8_STAGE(PG8_SB(0, 0), b2, voffB);
            PG8_BAR; PG8_WAIT_L(0); PG8_MMA(0, 1, At, B1); PG8_BAR;
            PG8_LDA(At, 0, 1); PG8_STAGE(PG8_SA(0, 0), a2, voffA);
            PG8_BAR; PG8_WAIT_L(0); PG8_MMA(1, 0, At, B0); PG8_BAR; PG8_SCHED;
            PG8_STAGE(PG8_SB(0, 1), b2 + hstep, voffB);
            PG8_WAIT_V(6); PG8_BAR; PG8_MMA(1, 1, At, B1); PG8_BAR;
            PG8_LDB(B0, 1, 0); PG8_SCHED; PG8_LDA(At, 1, 0); PG8_STAGE(PG8_SA(0, 1), a2 + hstep, voffA);
            PG8_WAIT_L(8); PG8_BAR; PG8_WAIT_L(0); PG8_MMA(0, 0, At, B0); PG8_BAR; PG8_SCHED;
            PG8_LDB(B1, 1, 1); PG8_STAGE(PG8_SB(1, 0), b3, voffB);
            PG8_BAR; PG8_WAIT_L(0); PG8_MMA(0, 1, At, B1); PG8_BAR;
            PG8_LDA(At, 1, 1); PG8_STAGE(PG8_SA(1, 0), a3, voffA);
            PG8_BAR; PG8_WAIT_L(0); PG8_MMA(1, 0, At, B0); PG8_BAR; PG8_SCHED;
            PG8_STAGE(PG8_SB(1, 1), b3 + hstep, voffB);
            PG8_WAIT_V(6); PG8_BAR; PG8_MMA(1, 1, At, B1); PG8_BAR;
            }
        }
        if constexpr (ALIGN_EPI) { if (wr == 0) PG8_BAR; }
        if constexpr (F8) asm volatile("s_nop 15\n\ts_nop 15" ::: "memory");
        if (!cur.split) { E(acc, cur, wr, wc, fr, fq, 0xffffu); }
        if (!has_next) break;
#pragma unroll
        for (int a = 0; a < 2; ++a)
#pragma unroll
            for (int b = 0; b < 2; ++b)
#pragma unroll
                for (int m = 0; m < 4; ++m)
#pragma unroll
                    for (int n = 0; n < 2; ++n) acc[a][b][m][n] = (f32x4){0.f, 0.f, 0.f, 0.f};
        cur = nxt; cA = nA; cB = nB; ++ui;
        if constexpr (ALIGN_EPI) { if (wr == 1) PG8_BAR; }
    }
    PG8_WAIT_V(0);
    if constexpr (!ALIGN_EPI) { if (wr == 0) PG8_BAR; }
    PG8_BAR;
    if (cur.split) {
        const __amdgpu_buffer_rsrc_t rs = __builtin_amdgcn_make_buffer_rsrc((void*)(S.slab + (size_t)S.c * SLAB_BYTES), (short)0, (int)SLAB_BYTES, 0x00020000);
#pragma unroll
        for (int ai = 0; ai < 2; ++ai)
#pragma unroll
            for (int m = 0; m < 4; ++m)
#pragma unroll
                for (int bj = 0; bj < 2; ++bj) { const f32x4 a0 = acc[ai][bj][m][0], a1 = acc[ai][bj][m][1]; u32x4 w; w.x = cvtpk(a0[0], a0[1]); w.y = cvtpk(a0[2], a0[3]); w.z = cvtpk(a1[0], a1[1]); w.w = cvtpk(a1[2], a1[3]);
                    __builtin_amdgcn_raw_buffer_store_b128(w, rs, tid * 16, (((ai * 4 + m) * 2 + bj) * 512) * 16, 16); }
        asm volatile("s_waitcnt vmcnt(0)" ::: "memory"); PG8_BAR;
        unsigned* cnt = S.cnt + 32 * cur.tile;
        if (tid == 0) __hip_atomic_fetch_add(cnt, 1u, __ATOMIC_RELAXED, __HIP_MEMORY_SCOPE_AGENT);
        const int R = cur.S < 16 ? cur.S : 16;
        if (cur.s < R) {
            if (wid == 0) { unsigned polls = 0;
                while ((unsigned)__builtin_amdgcn_readfirstlane(__hip_atomic_load(cnt, __ATOMIC_RELAXED, __HIP_MEMORY_SCOPE_AGENT)) < (unsigned)cur.S) { __builtin_amdgcn_s_sleep(2); if (++polls > (1u << 22)) break; }
                __builtin_amdgcn_fence(__ATOMIC_ACQUIRE, "agent"); asm volatile("s_waitcnt vmcnt(0)" ::: "memory"); }
            asm volatile("" ::: "memory"); PG8_BAR; asm volatile("" ::: "memory");
            unsigned mask = 0u;
#pragma unroll
            for (int p = 0; p < 16; ++p) if ((p % R) == cur.s) { mask |= 1u << p;
                f32x4 s0 = (f32x4){0.f, 0.f, 0.f, 0.f}, s1 = (f32x4){0.f, 0.f, 0.f, 0.f};
                for (int s2 = 0; s2 < cur.S; s2 += 4) {
                    u32x4 v[4];
#pragma unroll
                    for (int j = 0; j < 4; ++j) { const int sj = (s2 + j < cur.S) ? s2 + j : cur.s;
                        const __amdgpu_buffer_rsrc_t rp = __builtin_amdgcn_make_buffer_rsrc((void*)(S.slab + (size_t)(cur.xw + 8 * sj * cur.rx) * SLAB_BYTES), (short)0, (int)SLAB_BYTES, 0x00020000);
                        v[j] = __builtin_amdgcn_raw_buffer_load_b128(rp, tid * 16, p * 512 * 16, 0); }
#pragma unroll
                    for (int j = 0; j < 4; ++j) if (s2 + j < cur.S) {
                        s0[0] += __uint_as_float(v[j].x << 16); s0[1] += __uint_as_float(v[j].x & 0xffff0000u); s0[2] += __uint_as_float(v[j].y << 16); s0[3] += __uint_as_float(v[j].y & 0xffff0000u);
                        s1[0] += __uint_as_float(v[j].z << 16); s1[1] += __uint_as_float(v[j].z & 0xffff0000u); s1[2] += __uint_as_float(v[j].w << 16); s1[3] += __uint_as_float(v[j].w & 0xffff0000u); } }
                acc[p >> 3][p & 1][(p >> 1) & 3][0] = s0; acc[p >> 3][p & 1][(p >> 1) & 3][1] = s1; }
            E(acc, cur, wr, wc, fr, fq, mask);
        }
    }
#undef PG8_SA
#undef PG8_SB
#undef PG8_STAGE
#undef PG8_LDA
#undef PG8_LDB
#undef PG8_MMA
#undef PG8_WAIT_V
#undef PG8_WAIT_L
#undef PG8_BAR
#undef PG8_SCHED
}
}
#define GAS __attribute__((address_space(1)))
#define LAS __attribute__((address_space(3)))
typedef unsigned short bf16;
typedef unsigned v4u __attribute__((ext_vector_type(4)));
typedef unsigned v2u __attribute__((ext_vector_type(2)));
typedef float f32x4 __attribute__((ext_vector_type(4)));
typedef short bf16x8 __attribute__((ext_vector_type(8)));
typedef short s16x4 __attribute__((ext_vector_type(4)));
typedef GAS unsigned gu32;
#define LDS_WAIT() asm volatile("s_waitcnt lgkmcnt(0)" ::: "memory")
#define VM_WAIT() asm volatile("s_waitcnt vmcnt(0)" ::: "memory")
using pg8::cvtpk;
__device__ __forceinline__ float bf_lo(unsigned w) { return __uint_as_float(w << 16); }
__device__ __forceinline__ float bf_hi(unsigned w) { return __uint_as_float(w & 0xffff0000u); }
__device__ __forceinline__ float wave_sum(float v) {
#pragma unroll
    for (int o = 1; o < 64; o <<= 1) v += __shfl_xor(v, o);
    return v;
}
__device__ __forceinline__ bf16x8 mk8(v4u a) { return __builtin_bit_cast(bf16x8, a); }
#define MFMA16(a, b, c) __builtin_amdgcn_mfma_f32_16x16x32_bf16((a), (b), (c), 0, 0, 0)
#define XB_TMO      128
#define XB_XCNT(j)  (256  + 64 * (j))
#define XB_XSUB(j)  (1280 + 64 * (j))
#define XB_XGEN(j)  (2304 + 64 * (j))
#define XB_TOP      3328
#define XB_TOPGEN   3392
#define XCD_BAR_WORDS 3456
#define XB_SPIN_CAP (1u << 18)

__device__ __forceinline__ unsigned xb_ld(unsigned* p)              { return __hip_atomic_load(p, __ATOMIC_RELAXED, __HIP_MEMORY_SCOPE_AGENT); }
__device__ __forceinline__ unsigned xb_add(unsigned* p, unsigned v) { return __hip_atomic_fetch_add(p, v, __ATOMIC_RELAXED, __HIP_MEMORY_SCOPE_AGENT); }
__device__ __forceinline__ unsigned xb_xcc_id() { return (unsigned)__builtin_amdgcn_s_getreg((3 << 11) | 20) & 0xFu; }
#define XB_SPIN(cond, bar) do { unsigned _sp = 0; while (cond) { __builtin_amdgcn_s_sleep(1); \
    if ((++_sp & 255u) == 0u) { if (xb_ld(&(bar)[XB_TMO])) break; if (_sp > XB_SPIN_CAP) { atomicAdd(&(bar)[XB_TMO], 1u); break; } } } } while (0)

struct XcdBarrier {
    unsigned* bar; unsigned x;
    volatile LAS unsigned* st;
};

__device__ __forceinline__ XcdBarrier xcd_barrier_post(unsigned* bar, volatile LAS unsigned* st) {
    XcdBarrier b; b.bar = bar; b.x = xb_xcc_id(); b.st = st;
    if (threadIdx.x == 0) (void)xb_add(&bar[XB_XCNT(b.x)], 1u);
    return b;
}
__device__ __forceinline__ void xcd_barrier_complete(unsigned* bar, unsigned x, unsigned& nloc, unsigned& nx) {
    const unsigned G = gridDim.x * gridDim.y * gridDim.z;
    unsigned sum, cnt, mine, sp = 0u;
    for (;;) {
        sum = 0u; cnt = 0u; mine = 0u;
#pragma unroll
        for (unsigned j = 0; j < 16; ++j) { const unsigned c = xb_ld(&bar[XB_XCNT(j)]); sum += c; cnt += (c > 0u) ? 1u : 0u; mine = (j == x) ? c : mine; }
        if (sum == G) break;
        __builtin_amdgcn_s_sleep(1);
        if ((++sp & 255u) == 0u) { if (xb_ld(&bar[XB_TMO])) break; if (sp > XB_SPIN_CAP) { atomicAdd(&bar[XB_TMO], 1u); break; } }
    }
    nloc = mine > 0u ? mine : 1u; nx = cnt > 0u ? cnt : 1u;
}

__device__ __forceinline__ void xcd_barrier(const XcdBarrier& b) {
    asm volatile("s_waitcnt vmcnt(0)" ::: "memory");
    __syncthreads();
    if (threadIdx.x == 0) {
        unsigned* bar = b.bar;
        __builtin_amdgcn_s_waitcnt(0);
        unsigned nloc = b.st[0], nx = b.st[1];
        if (nloc == 0u) { xcd_barrier_complete(bar, b.x, nloc, nx); b.st[0] = nloc; b.st[1] = nx; }
        const unsigned old = xb_add(&bar[XB_XSUB(b.x)], 1u);
        const unsigned gen = old / nloc;
        if (old + 1u == (gen + 1u) * nloc) {
            __builtin_amdgcn_fence(__ATOMIC_RELEASE, "agent");
            asm volatile("s_waitcnt vmcnt(0)" ::: "memory");
            const unsigned og = xb_add(&bar[XB_TOP], 1u);
            const unsigned tg = og / nx;
            if (og + 1u == (tg + 1u) * nx) xb_add(&bar[XB_TOPGEN], 1u);
            else XB_SPIN(xb_ld(&bar[XB_TOPGEN]) == tg, bar);
            __builtin_amdgcn_fence(__ATOMIC_ACQUIRE, "agent");
            xb_add(&bar[XB_XGEN(b.x)], 1u);
            asm volatile("s_waitcnt vmcnt(0)" ::: "memory");
        } else {
            XB_SPIN(xb_ld(&bar[XB_XGEN(b.x)]) == gen, bar);
            __builtin_amdgcn_fence(__ATOMIC_ACQUIRE, "agent");
            asm volatile("s_waitcnt vmcnt(0)" ::: "memory");
        }
    }
    __syncthreads();
}

struct Args { const float* in[27]; float* out; unsigned char* ws; int ph_lo, ph_hi; };
struct Frame {
    LAS unsigned char* lds; volatile LAS unsigned* MISC;
    int tid, lane, wave, vcu, G;
    const Args* a;
};
#define A_IN(k) (F.a->in[k])
#define A_WS(T, off) ((T*)(F.a->ws + (off)))
#define A_OUT (F.a->out)
#define A_XF (F.a->out + OUT_Y)
#define A_SSQ(k) ((unsigned long long*)(F.a->ws + CTL_SSQ_BYTE) + (size_t)(k) * M)

template <bool F8>
__device__ __forceinline__ void p0_load(const float* W, int ldn, const float* gain, int k0, int n0, int lane, f32x4 (&va)[8], f32x4 (&vb)[8], float (&ga)[8], float (&gb)[8]) {
    const int nq = lane & 15, kr = lane >> 4; const float gsc = F8 ? 64.f : 1.f;
#pragma unroll
    for (int j = 0; j < 8; ++j) { const int ka = k0 + 8 * j + 2 * kr;
        va[j] = *(const f32x4*)(W + (size_t)ka * ldn + n0 + 4 * nq); vb[j] = *(const f32x4*)(W + (size_t)(ka + 1) * ldn + n0 + 4 * nq);
        ga[j] = gain ? gain[ka] * gsc : gsc; gb[j] = gain ? gain[ka + 1] * gsc : gsc; }
}
template <int MODE, bool F8>
__device__ __forceinline__ void p0_store(int ldk, bf16* WT, LAS unsigned char* scr, int k0, int n0, int lane, const f32x4 (&va)[8], const f32x4 (&vb)[8], const float (&ga)[8], const float (&gb)[8]) {
    const int nq = lane & 15, kr = lane >> 4;
#pragma unroll
    for (int j = 0; j < 8; ++j)
#pragma unroll
        for (int e = 0; e < 4; ++e) *(LAS unsigned*)(scr + (4 * nq + e) * 128 + ((j ^ (nq & 7)) << 4) + 4 * kr) = cvtpk(va[j][e] * ga[j], vb[j][e] * gb[j]);
    LDS_WAIT(); asm volatile("" ::: "memory");
#pragma unroll
    for (int i = 0; i < 8; ++i) {
        const int n = (lane >> 3) + 8 * i, c = lane & 7;
        const v4u o = *(const LAS v4u*)(scr + n * 128 + ((c ^ ((n >> 2) & 7)) << 4));
        const int nn = n0 + n;
        const int r = (MODE == 0) ? nn : (32 * (nn >> 4) + (nn & 15) + (MODE == 2 ? 16 : 0));
        if constexpr (F8) { v2u q; q.x = pg8::pack4_fp8(bf_lo(o.x), bf_hi(o.x), bf_lo(o.y), bf_hi(o.y)); q.y = pg8::pack4_fp8(bf_lo(o.z), bf_hi(o.z), bf_lo(o.w), bf_hi(o.w));
            *(v2u*)((unsigned char*)WT + (size_t)r * ldk + k0 + 8 * c) = q; }
        else *(v4u*)(WT + (size_t)r * ldk + k0 + 8 * c) = o;
    }
    LDS_WAIT(); asm volatile("" ::: "memory");
}
template <int MODE, bool F8 = false>
__device__ __forceinline__ void p0_matrix(Frame& F, const float* W, int K, int ldn, int ncols, const float* gain, bf16* WT, int gw, int NGW) {
    LAS unsigned char* scr = F.lds + F.wave * 18432;
    const int ntn = ncols / 64, nt = (K / 64) * ntn;
    const int ldk = (K == D) ? LDX : (K == FFN ? LDH : K);
    for (int it = 2 * gw; it < nt; it += 2 * NGW) { const int it2 = it + 1;
        f32x4 va[8], vb[8], wa[8], wb[8]; float ga[8], gb[8], ha[8], hb[8];
        p0_load<F8>(W, ldn, gain, (it / ntn) * 64, (it % ntn) * 64, F.lane, va, vb, ga, gb);
        if (it2 < nt) p0_load<F8>(W, ldn, gain, (it2 / ntn) * 64, (it2 % ntn) * 64, F.lane, wa, wb, ha, hb);
        p0_store<MODE, F8>(ldk, WT, scr, (it / ntn) * 64, (it % ntn) * 64, F.lane, va, vb, ga, gb);
        if (it2 < nt) p0_store<MODE, F8>(ldk, WT, scr, (it2 / ntn) * 64, (it2 % ntn) * 64, F.lane, wa, wb, ha, hb); }
}
__device__ __forceinline__ void p0_late_weights(Frame& F, int gw, int NGW) {
    p0_matrix<0>(F, A_IN(18), D, D, D, nullptr, A_WS(bf16, WS_WOUT), gw, NGW);
    p0_matrix<1, true>(F, A_IN(20), D, FFN, FFN, A_IN(19), A_WS(bf16, WS_W2GU), gw, NGW);
    p0_matrix<2, true>(F, A_IN(21), D, FFN, FFN, A_IN(19), A_WS(bf16, WS_W2GU), gw, NGW);
    p0_matrix<0, true>(F, A_IN(22), FFN, D, D, nullptr, A_WS(bf16, WS_W2D), gw, NGW);
}
__device__ __forceinline__ void p0_ple_weights(Frame& F, int gw, int NGW) {
    p0_matrix<0, true>(F, A_IN(24), D, D, D, A_IN(23), A_WS(bf16, WS_WPG), gw, NGW);
}
__device__ __forceinline__ void p0_prologue(Frame& F) {
    const int gw = F.vcu * NWAVES + F.wave, NGW = F.G * NWAVES;
    p0_matrix<1>(F, A_IN(10), D, FFN, FFN, A_IN(9), A_WS(bf16, WS_W1GU), gw, NGW);
    p0_matrix<2>(F, A_IN(11), D, FFN, FFN, A_IN(9), A_WS(bf16, WS_W1GU), gw, NGW);
    p0_matrix<0>(F, A_IN(12), FFN, D, D, nullptr, A_WS(bf16, WS_W1D), gw, NGW);
    p0_matrix<0>(F, A_IN(14), D, NINF, NIN, A_IN(13), A_WS(bf16, WS_WIN), gw, NGW);
    p0_matrix<0>(F, A_IN(25), PLE, D, D, nullptr, A_WS(bf16, WS_WPP), gw, NGW);
    for (int row = gw; row < M; row += NGW) {
        const float* src = row < MP ? A_IN(0) + (size_t)row * D : A_IN(1) + (size_t)(row - MP) * D;
        const f32x4* xr = (const f32x4*)src + F.lane; v2u* o = (v2u*)(A_WS(bf16, WS_XB) + (size_t)row * LDX) + F.lane; float s = 0.f;
#pragma unroll
        for (int j = 0; j < 16; ++j) { const f32x4 v = xr[64 * j]; s += (v[0] * v[0] + v[1] * v[1]) + (v[2] * v[2] + v[3] * v[3]); v2u w; w.x = cvtpk(v[0], v[1]); w.y = cvtpk(v[2], v[3]); o[64 * j] = w; }
        s = wave_sum(s);
        if (F.lane == 0) A_SSQ(0)[row] = pg8::ssq_fix(s);
    }
    const int gt = F.vcu * NWAVES * 64 + F.tid, NGT = F.G * NWAVES * 64;
    for (int i = gt; i < M * (PLE / 4); i += NGT) {
        const f32x4 v = (i < MP * (PLE / 4)) ? ((const f32x4*)A_IN(7))[i] : ((const f32x4*)A_IN(8))[i - MP * (PLE / 4)];
        v2u w; w.x = cvtpk(v[0], v[1]); w.y = cvtpk(v[2], v[3]); ((v2u*)A_WS(bf16, WS_PB))[i] = w;
    }
    for (int i = gt; i < 8 * D; i += NGT) { const int j = i / D, k = i % D; A_WS(float, WS_WIF)[i] = A_IN(13)[k] * A_IN(14)[(size_t)k * NINF + NIN + j]; }
}

__device__ __forceinline__ void gates_rows(Frame& F) {
    const int gw = F.vcu * NWAVES + F.wave, NGW = F.G * NWAVES;
    float acc[5][8];
#pragma unroll
    for (int r = 0; r < 5; ++r)
#pragma unroll
        for (int jj = 0; jj < 8; ++jj) acc[r][jj] = 0.f;
    for (int j = 0; j < 16; ++j) {
        f32x4 wv[8];
#pragma unroll
        for (int jj = 0; jj < 8; ++jj) wv[jj] = *(const f32x4*)(A_WS(float, WS_WIF) + jj * D + 256 * j + 4 * F.lane);
#pragma unroll
        for (int r = 0; r < 5; ++r) { const int row = gw + NGW * r;
            if (row < M) { const v2u xw = *(const v2u*)(A_WS(bf16, WS_XB) + (size_t)row * D + 256 * j + 4 * F.lane); f32x4 x; x[0] = bf_lo(xw.x); x[1] = bf_hi(xw.x); x[2] = bf_lo(xw.y); x[3] = bf_hi(xw.y);
#pragma unroll
                for (int jj = 0; jj < 8; ++jj) acc[r][jj] += (x[0] * wv[jj][0] + x[1] * wv[jj][1]) + (x[2] * wv[jj][2] + x[3] * wv[jj][3]); } }
    }
#pragma unroll
    for (int r = 0; r < 5; ++r) { const int row = gw + NGW * r;
        if (row < M) { const float rs = pg8::rs_of(A_SSQ(1), row);
#pragma unroll
            for (int jj = 0; jj < 8; ++jj) { const float s = wave_sum(acc[r][jj]); if (F.lane == jj) A_WS(float, WS_GATES)[(size_t)row * 8 + jj] = s * rs + A_IN(15)[jj]; } } }
}

__device__ __forceinline__ bf16x8 cvt8(const f32x4 a, const f32x4 b) { v4u w; w.x = cvtpk(a[0], a[1]); w.y = cvtpk(a[2], a[3]); w.z = cvtpk(b[0], b[1]); w.w = cvtpk(b[2], b[3]); return mk8(w); }
__device__ __forceinline__ s16x4 tr16(LAS unsigned char* p) { typedef short v4i16_t __attribute__((ext_vector_type(4))); return __builtin_bit_cast(s16x4, __builtin_amdgcn_ds_read_tr16_b64_v4i16((LAS v4i16_t*)p)); }
constexpr int SB_VLD = 288, SB_VBYTES = 64 * SB_VLD;
__device__ __forceinline__ void sb_unit(Frame& F, int unit, LAS unsigned char* vl) {
    const int lane = F.lane, i16 = lane & 15, g = lane >> 4;
    const int h = unit & 15, qrow0 = (unit >> 4) * 16;
    const bool samp = qrow0 >= MP;
    int pos0, krow_base; const float* ck = nullptr; const float* cv = nullptr;
    if (!samp) { pos0 = qrow0 & (SEQ - 1); krow_base = qrow0 - pos0; }
    else { const int bs = (qrow0 - MP) >> 5; pos0 = PAST + ((qrow0 - MP) & 31); krow_base = MP + bs * DSEQ - PAST;
           ck = A_IN(2) + (size_t)bs * PAST * SBW + h * SBD; cv = A_IN(3) + (size_t)bs * PAST * SBW + h * SBD; }
    const int qpos = pos0 + i16;
    bf16x8 qf[4];
#pragma unroll
    for (int ks = 0; ks < 4; ++ks) qf[ks] = *(const bf16x8*)(A_WS(bf16, WS_QB) + (size_t)(qrow0 + i16) * SBW + h * SBD + 32 * ks + 8 * g);
    f32x4 o[8];
#pragma unroll
    for (int d = 0; d < 8; ++d) o[d] = (f32x4){0.f, 0.f, 0.f, 0.f};
    float P = 1.0f;
    for (int kend = pos0 + 16; kend > 0; kend -= 64) {
        const int kbase = kend - 64;
        f32x4 beta[4], omb[4];
        if (!samp) {
            v4u vv[16]; bf16x8 kf[4][4];
#pragma unroll
            for (int i = 0; i < 16; ++i) { const int key = (lane >> 4) + 4 * i, dc = lane & 15; int pos = kbase + key; pos = pos < 0 ? 0 : pos;
                vv[i] = *(const v4u*)(A_WS(bf16, WS_VB) + (size_t)(krow_base + pos) * SBW + h * SBD + 8 * dc); }
#pragma unroll
            for (int kt = 0; kt < 4; ++kt) { int t0 = kbase + 16 * kt; t0 = t0 < 0 ? 0 : t0;
#pragma unroll
                for (int ks = 0; ks < 4; ++ks) kf[kt][ks] = *(const bf16x8*)(A_WS(bf16, WS_KB) + (size_t)(krow_base + t0 + i16) * SBW + h * SBD + 32 * ks + 8 * g); }
#pragma unroll
            for (int i = 0; i < 16; ++i) { const int key = (lane >> 4) + 4 * i, dc = lane & 15; *(LAS v4u*)(vl + key * SB_VLD + dc * 16) = vv[i]; }
#pragma unroll
            for (int kt = 0; kt < 4; ++kt) { const int t0 = kbase + 16 * kt;
                f32x4 acc = (f32x4){0.f, 0.f, 0.f, 0.f};
#pragma unroll
                for (int ks = 0; ks < 4; ++ks) acc = MFMA16(kf[kt][ks], qf[ks], acc);
#pragma unroll
                for (int r = 0; r < 4; ++r) { const float z = acc[r]; const float e = __expf(-fabsf(z)); const float rr = __builtin_amdgcn_rcpf(1.0f + e), er = e * rr;
                    const bool ok = t0 >= 0 && (t0 + 4 * g + r) < qpos;
                    beta[kt][r] = ok ? (z >= 0.f ? rr : er) : 0.f; omb[kt][r] = ok ? (z >= 0.f ? er : rr) : 1.f; } }
        } else {
#pragma unroll
        for (int i = 0; i < 16; ++i) {
            const int key = (lane >> 4) + 4 * i, dc = lane & 15; int pos = kbase + key; pos = pos < 0 ? 0 : pos;
            v4u val;
            if (samp && (kbase + 4 * i) < PAST) { const float* p = cv + (size_t)pos * SBW + 8 * dc; const f32x4 a = *(const f32x4*)p, b = *(const f32x4*)(p + 4); val = __builtin_bit_cast(v4u, cvt8(a, b)); }
            else val = *(const v4u*)(A_WS(bf16, WS_VB) + (size_t)(krow_base + pos) * SBW + h * SBD + 8 * dc);
            *(LAS v4u*)(vl + key * SB_VLD + dc * 16) = val;
        }
#pragma unroll
        for (int kt = 0; kt < 4; ++kt) {
            const int t0 = kbase + 16 * kt;
            if (t0 < 0) { beta[kt] = (f32x4){0.f, 0.f, 0.f, 0.f}; omb[kt] = (f32x4){1.f, 1.f, 1.f, 1.f}; continue; }
            f32x4 acc = (f32x4){0.f, 0.f, 0.f, 0.f};
            if (samp && t0 < PAST) {
#pragma unroll
                for (int ks = 0; ks < 4; ++ks) { const float* p = ck + (size_t)(t0 + i16) * SBW + 32 * ks + 8 * g; const f32x4 a = *(const f32x4*)p, b = *(const f32x4*)(p + 4);
                    acc = MFMA16(cvt8(a, b), qf[ks], acc); }
            } else {
#pragma unroll
                for (int ks = 0; ks < 4; ++ks) { const bf16x8 kf = *(const bf16x8*)(A_WS(bf16, WS_KB) + (size_t)(krow_base + t0 + i16) * SBW + h * SBD + 32 * ks + 8 * g); acc = MFMA16(kf, qf[ks], acc); }
            }
#pragma unroll
            for (int r = 0; r < 4; ++r) { const float z = acc[r]; const float e = __expf(-fabsf(z)); const float rr = __builtin_amdgcn_rcpf(1.0f + e), er = e * rr;
                const bool ok = (t0 + 4 * g + r) < qpos;
                beta[kt][r] = ok ? (z >= 0.f ? rr : er) : 0.f; omb[kt][r] = ok ? (z >= 0.f ? er : rr) : 1.f; }
        }
        }
        f32x4 a[4]; float Pc = P;
#pragma unroll
        for (int kt = 3; kt >= 0; --kt) {
            const float s2 = omb[kt][3], s1 = s2 * omb[kt][2], s0 = s1 * omb[kt][1], T = s0 * omb[kt][0];
            const float x1 = __shfl_xor(T, 16), x2 = __shfl_xor(T, 32), x3 = __shfl_xor(T, 48);
            const float Sg = (((g ^ 1) > g) ? x1 : 1.f) * (((g ^ 2) > g) ? x2 : 1.f) * (((g ^ 3) > g) ? x3 : 1.f);
            const float base = Sg * Pc;
            a[kt][0] = beta[kt][0] * s0 * base; a[kt][1] = beta[kt][1] * s1 * base; a[kt][2] = beta[kt][2] * s2 * base; a[kt][3] = beta[kt][3] * base;
            Pc *= (T * x1) * (x2 * x3);
        }
        P = Pc;
#pragma unroll
        for (int ks2 = 0; ks2 < 2; ++ks2) {
            const bf16x8 af = cvt8(a[2 * ks2], a[2 * ks2 + 1]);
#pragma unroll
            for (int d = 0; d < 8; ++d) {
                LAS unsigned char* p = vl + (32 * ks2 + 4 * g + (i16 >> 2)) * SB_VLD + (16 * d + 4 * (i16 & 3)) * 2;
                const s16x4 lo = tr16(p), hi = tr16(p + 16 * SB_VLD);
                const bf16x8 vf = __builtin_shufflevector(lo, hi, 0, 1, 2, 3, 4, 5, 6, 7);
                o[d] = MFMA16(vf, af, o[d]);
            }
        }
        if (__all(P < 7.8886090522101181e-31f)) break;
    }
    float ss = 0.f;
#pragma unroll
    for (int d = 0; d < 8; ++d) ss += (o[d][0] * o[d][0] + o[d][1] * o[d][1]) + (o[d][2] * o[d][2] + o[d][3] * o[d][3]);
    ss += __shfl_xor(ss, 16); ss += __shfl_xor(ss, 32);
    const float rinv = rsqrtf(ss * (1.0f / SBD) + EPS);
    bf16* mrow = A_WS(bf16, WS_MIX) + (size_t)(qrow0 + i16) * LDX + h * SBD + 4 * g;
#pragma unroll
    for (int d = 0; d < 8; ++d) { const f32x4 gv = *(const f32x4*)(A_IN(16) + h * SBD + 16 * d + 4 * g);
        v2u w; w.x = cvtpk(o[d][0] * rinv * gv[0], o[d][1] * rinv * gv[1]); w.y = cvtpk(o[d][2] * rinv * gv[2], o[d][3] * rinv * gv[3]); *(v2u*)(mrow + 16 * d) = w; }
}

constexpr int ML_QS = 0, ML_LD = 528, ML_KS = 33792, ML_TLD = 144, ML_VS = 67584, ML_VSS = 76800, ML_PS = 86016, ML_TAB = 95232;
__device__ __forceinline__ float scan_add(float v, int lane) {
#pragma unroll
    for (int o = 1; o < 64; o <<= 1) { const float t = __shfl_up(v, o); v = (lane >= o) ? v + t : v; }
    return v;
}
__device__ __forceinline__ float scan_max(float v, int lane) {
#pragma unroll
    for (int o = 1; o < 64; o <<= 1) { const float t = __shfl_up(v, o); v = (lane >= o) ? fmaxf(v, t) : v; }
    return v;
}
__device__ __forceinline__ void mlstm_scan(Frame& F, int seq, int h, int vblk, bool samp, bool doval, bool doden) {
    LAS unsigned char* L = F.lds; const int tid = F.tid, lane = F.lane, w = F.wave, i16 = lane & 15, g = lane >> 4;
    const int nsteps = samp ? 1 : SEQ / CHUNK, Lvalid = samp ? DSEQ : CHUNK;
    const int row0 = samp ? MP + seq * DSEQ : seq * SEQ, vbase = vblk * 64; const bool vw = w < 4;
    LAS float* tab = (LAS float*)(L + ML_TAB); LAS float* nvec = tab + 192; LAS float* dpart = tab + 448; LAS float* rsp = tab + 960;
    f32x4 C[16]; float m;
    if (samp) { const float* c0 = A_IN(4) + ((size_t)(seq * MLH + h) * MLV + vbase + 16 * (w & 3) + i16) * MLQK + 4 * g;
#pragma unroll
        for (int dt = 0; dt < 16; ++dt) C[dt] = *(const f32x4*)(c0 + 16 * dt);
        m = A_IN(6)[seq * MLH + h]; if (tid < MLQK) nvec[tid] = A_IN(5)[(seq * MLH + h) * MLQK + tid]; }
    else {
#pragma unroll
        for (int dt = 0; dt < 16; ++dt) C[dt] = (f32x4){0.f, 0.f, 0.f, 0.f};
        m = 0.f; if (tid < MLQK) nvec[tid] = 0.f; }
    v4u qreg[4], kreg[4], vreg; f32x4 sc4; float aav, wprev_n;
#define ML_PREFETCH(cc) do { const int rowc_ = row0 + CHUNK * (cc); \
        _Pragma("unroll") for (int i = 0; i < 4; ++i) { const int id = tid + 512 * i, r = id >> 5, c16 = id & 31; \
            if (r < Lvalid) { qreg[i] = *(const v4u*)(A_WS(bf16, WS_MQ) + (size_t)(rowc_ + r) * 1024 + h * MLQK + 8 * c16); kreg[i] = *(const v4u*)(A_WS(bf16, WS_MK) + (size_t)(rowc_ + r) * 1024 + h * MLQK + 8 * c16); } \
            else { qreg[i] = (v4u){0u, 0u, 0u, 0u}; kreg[i] = (v4u){0u, 0u, 0u, 0u}; } } \
        { const int r = tid >> 3, c8 = tid & 7; \
            if (r < Lvalid) vreg = *(const v4u*)(A_WS(bf16, WS_MV) + (size_t)(rowc_ + r) * 2048 + h * MLV + vbase + 8 * c8); else vreg = (v4u){0u, 0u, 0u, 0u}; } \
        sc4 = *(const f32x4*)(GS + ((size_t)(cc) * 64 + lane) * 4); aav = GS[16384 + (cc) * 64 + lane]; wprev_n = GS[20480 + (cc)]; } while (0)
    float* GS = A_WS(float, WS_MLS) + (size_t)blockIdx.x * 21504;
    {   LAS float* ptab = (LAS float*)(L + ML_QS);
        float pb[8], pa[8], pA[8];
#pragma unroll
        for (int k = 0; k < 8; ++k) { const int cc = w + 8 * k; pb[k] = 0.f; pa[k] = -INFINITY; pA[k] = -INFINITY;
            if (cc < nsteps) { float gi, gf; const int rowc_ = row0 + CHUNK * cc;
                if (lane < Lvalid) { gi = A_WS(float, WS_GATES)[(size_t)(rowc_ + lane) * 8 + h]; gf = A_WS(float, WS_GATES)[(size_t)(rowc_ + lane) * 8 + 4 + h]; } else { gi = -INFINITY; gf = 1e30f; }
                const float lf = fminf(gf, 0.f) - log1pf(expf(-fabsf(gf)));
                pb[k] = scan_add(lf, lane); pa[k] = gi - pb[k]; pA[k] = scan_max(pa[k], lane);
                if (lane == Lvalid - 1) { ptab[2 * cc] = pb[k]; ptab[2 * cc + 1] = pA[k]; } } }
        __syncthreads();
        const float Bc = lane < nsteps ? ptab[2 * lane] : 0.f, Ac = lane < nsteps ? ptab[2 * lane + 1] : -INFINITY;
        float mcur = m, mstart = m, mend = m;
        for (int cc = 0; cc < nsteps; ++cc) { const float mn = __shfl(Bc, cc) + fmaxf(mcur, __shfl(Ac, cc)); if (lane == cc) { mstart = mcur; mend = mn; } mcur = mn; }
        m = mcur;
#pragma unroll
        for (int k = 0; k < 8; ++k) { const int cc = w + 8 * k;
            if (cc < nsteps) { const float mc = __shfl(mstart, cc), mnew = __shfl(mend, cc), blast = __shfl(pb[k], Lvalid - 1);
                const float mrow = pb[k] + fmaxf(mc, pA[k]);
                f32x4 o; o[0] = expf(blast + pa[k] - mnew); o[1] = expf(pb[k] + mc - mrow); o[2] = expf(-mrow); o[3] = pb[k] - mrow;
                *(f32x4*)(GS + ((size_t)cc * 64 + lane) * 4) = o; GS[16384 + cc * 64 + lane] = pa[k];
                if (lane == 0) GS[20480 + cc] = expf(blast + mc - mnew); } }
        asm volatile("s_waitcnt vmcnt(0)" ::: "memory");
        __syncthreads(); }
    ML_PREFETCH(0);
    for (int c = 0; c < nsteps; ++c) {
        const int rowc = row0 + CHUNK * c;
        const float wtok = sc4[0], winter = sc4[1], emr = sc4[2], uu = sc4[3], aa = aav, wprev = wprev_n;
#pragma unroll
        for (int i = 0; i < 4; ++i) { const int id = tid + 512 * i, r = id >> 5, c16 = id & 31; *(LAS v4u*)(L + ML_QS + r * ML_LD + c16 * 16) = qreg[i]; *(LAS v4u*)(L + ML_KS + r * ML_LD + c16 * 16) = kreg[i]; }
        { const int r = tid >> 3, c8 = tid & 7; const float wt = __shfl(wtok, r);
            *(LAS v4u*)(L + ML_VS + r * ML_TLD + c8 * 16) = vreg;
            v4u sv; sv.x = cvtpk(bf_lo(vreg.x) * wt, bf_hi(vreg.x) * wt); sv.y = cvtpk(bf_lo(vreg.y) * wt, bf_hi(vreg.y) * wt); sv.z = cvtpk(bf_lo(vreg.z) * wt, bf_hi(vreg.z) * wt); sv.w = cvtpk(bf_lo(vreg.w) * wt, bf_hi(vreg.w) * wt);
            *(LAS v4u*)(L + ML_VSS + r * ML_TLD + c8 * 16) = sv; }
        if (w == 0) { tab[lane] = wtok; tab[64 + lane] = winter; tab[128 + lane] = emr; tab[1088 + lane] = uu; tab[1152 + lane] = aa; }
        if (c + 1 < nsteps) ML_PREFETCH(c + 1);
        __syncthreads();
#define SB0() __builtin_amdgcn_sched_barrier(0)
        {   if (!vw) { const int tt = w - 4; float rsum = 0.f; const float ut = tab[1088 + 16 * tt + i16];
            bf16x8 fq[8];
#pragma unroll
            for (int ks = 0; ks < 8; ++ks) fq[ks] = *(const LAS bf16x8*)(L + ML_QS + (16 * tt + i16) * ML_LD + (32 * ks + 8 * g) * 2);
#pragma unroll
            for (int st = 0; st < 4; ++st) { f32x4 acc = (f32x4){0.f, 0.f, 0.f, 0.f};
                if (st <= tt) { bf16x8 fk[8];
#pragma unroll
                    for (int ks = 0; ks < 8; ++ks) fk[ks] = *(const LAS bf16x8*)(L + ML_KS + (16 * st + i16) * ML_LD + (32 * ks + 8 * g) * 2);
                    SB0();
#pragma unroll
                    for (int ks = 0; ks < 8; ++ks) acc = MFMA16(fk[ks], fq[ks], acc);
                    SB0(); }
                f32x4 pv; const f32x4 as4 = *(const LAS f32x4*)(tab + 1152 + 16 * st + 4 * g);
#pragma unroll
                for (int r = 0; r < 4; ++r) { const float as = as4[r]; const bool ok = (st < tt) || (st == tt && (4 * g + r) <= i16); pv[r] = ok ? acc[r] * __expf(ut + as) : 0.f; }
                rsum += (pv[0] + pv[1]) + (pv[2] + pv[3]);
                v2u pw; pw.x = cvtpk(pv[0], pv[1]); pw.y = cvtpk(pv[2], pv[3]); *(LAS v2u*)(L + ML_PS + (16 * tt + i16) * ML_TLD + (16 * st + 4 * g) * 2) = pw; }
            rsum += __shfl_xor(rsum, 16); rsum += __shfl_xor(rsum, 32);
            if (g == 0) { rsp[(16 * tt + i16) * 2] = rsum; rsp[(16 * tt + i16) * 2 + 1] = 0.f; } }
            if (doden) { float dp = 0.f; v4u qq[4]; f32x4 nn0[4], nn1[4];
#pragma unroll
            for (int c4 = 0; c4 < 4; ++c4) { qq[c4] = *(const LAS v4u*)(L + ML_QS + lane * ML_LD + (32 * w + 8 * c4) * 2); nn0[c4] = *(const LAS f32x4*)(nvec + 32 * w + 8 * c4); nn1[c4] = *(const LAS f32x4*)(nvec + 32 * w + 8 * c4 + 4); }
#pragma unroll
            for (int c4 = 0; c4 < 4; ++c4) dp += (bf_lo(qq[c4].x) * nn0[c4][0] + bf_hi(qq[c4].x) * nn0[c4][1]) + (bf_lo(qq[c4].y) * nn0[c4][2] + bf_hi(qq[c4].y) * nn0[c4][3]) + (bf_lo(qq[c4].z) * nn1[c4][0] + bf_hi(qq[c4].z) * nn1[c4][1]) + (bf_lo(qq[c4].w) * nn1[c4][2] + bf_hi(qq[c4].w) * nn1[c4][3]);
            dpart[lane * 8 + w] = dp; } }
        f32x4 Y[4];
#pragma unroll
        for (int t2 = 0; t2 < 4; ++t2) Y[t2] = (f32x4){0.f, 0.f, 0.f, 0.f};
        if (vw && doval) {
#define ML_LDQ(dst, ks_) do { _Pragma("unroll") for (int t2 = 0; t2 < 4; ++t2) { const LAS unsigned char* qp = L + ML_QS + (16 * t2 + i16) * ML_LD + (32 * (ks_) + 4 * g) * 2; const v2u b0 = *(const LAS v2u*)qp, b1 = *(const LAS v2u*)(qp + 32); \
            dst[t2].x = b0.x; dst[t2].y = b0.y; dst[t2].z = b1.x; dst[t2].w = b1.y; } } while (0)
        v4u qa[4], qb[4];
        ML_LDQ(qa, 0);
#pragma unroll
        for (int ks = 0; ks < 8; ks += 2) {
            ML_LDQ(qb, ks + 1); SB0();
            { const bf16x8 af = cvt8(C[2 * ks], C[2 * ks + 1]);
#pragma unroll
              for (int t2 = 0; t2 < 4; ++t2) Y[t2] = MFMA16(af, mk8(qa[t2]), Y[t2]); }
            SB0();
            if (ks + 2 < 8) ML_LDQ(qa, ks + 2);
            SB0();
            { const bf16x8 af = cvt8(C[2 * ks + 2], C[2 * ks + 3]);
#pragma unroll
              for (int t2 = 0; t2 < 4; ++t2) Y[t2] = MFMA16(af, mk8(qb[t2]), Y[t2]); }
            SB0(); }
#undef ML_LDQ
#pragma unroll
        for (int t2 = 0; t2 < 4; ++t2) Y[t2] = Y[t2] * tab[64 + 16 * t2 + i16];
#pragma unroll
        for (int dt = 0; dt < 16; ++dt) C[dt] = C[dt] * wprev;
#pragma unroll
        for (int ks = 0; ks < 2; ++ks) { LAS unsigned char* tp = L + (32 * ks + 8 * g + (i16 >> 2)) * ML_TLD + (16 * w + 4 * (i16 & 3)) * 2;
            LAS unsigned char* kp = L + ML_KS + (32 * ks + 8 * g + (i16 >> 2)) * ML_LD + (4 * (i16 & 3)) * 2;
            const s16x4 blo = tr16(tp + ML_VSS), bhi = tr16(tp + ML_VSS + 4 * ML_TLD);
            const bf16x8 B = __builtin_shufflevector(blo, bhi, 0, 1, 2, 3, 4, 5, 6, 7);
#pragma unroll
            for (int dh = 0; dh < 16; dh += 8) { s16x4 alo[8], ahi[8];
#pragma unroll
                for (int dt = 0; dt < 8; ++dt) { alo[dt] = tr16(kp + 32 * (dh + dt)); ahi[dt] = tr16(kp + 32 * (dh + dt) + 4 * ML_LD); }
                SB0();
#pragma unroll
                for (int dt = 0; dt < 8; ++dt) { const bf16x8 A = __builtin_shufflevector(alo[dt], ahi[dt], 0, 1, 2, 3, 4, 5, 6, 7); C[dh + dt] = MFMA16(A, B, C[dh + dt]); }
                SB0(); } }
        }
        __syncthreads();
        if (vw && doval) {
            s16x4 alo[2], ahi[2]; bf16x8 pb[2][4];
#pragma unroll
            for (int ks = 0; ks < 2; ++ks) { LAS unsigned char* tp = L + ML_VS + (32 * ks + 8 * g + (i16 >> 2)) * ML_TLD + (16 * w + 4 * (i16 & 3)) * 2; alo[ks] = tr16(tp); ahi[ks] = tr16(tp + 4 * ML_TLD);
#pragma unroll
                for (int t2 = 0; t2 < 4; ++t2) pb[ks][t2] = *(const LAS bf16x8*)(L + ML_PS + (16 * t2 + i16) * ML_TLD + (32 * ks + 8 * g) * 2); }
            SB0();
#pragma unroll
            for (int ks = 0; ks < 2; ++ks) { const bf16x8 A = __builtin_shufflevector(alo[ks], ahi[ks], 0, 1, 2, 3, 4, 5, 6, 7);
#pragma unroll
                for (int t2 = 0; t2 < 4; ++t2) Y[t2] = MFMA16(A, pb[ks][t2], Y[t2]); }
            SB0();
#pragma unroll
        for (int t2 = 0; t2 < 4; ++t2) { const int t = 16 * t2 + i16; if (t < Lvalid) *(f32x4*)(A_WS(float, WS_NUM) + (size_t)(rowc + t) * 2048 + h * MLV + vbase + 16 * w + 4 * g) = Y[t2]; }
        }
        if (doden) { if (tid < CHUNK) { float dq = 0.f;
#pragma unroll
            for (int j = 0; j < 8; ++j) dq += dpart[tid * 8 + j];
            const float den = tab[64 + tid] * dq + rsp[2 * tid] + rsp[2 * tid + 1]; const float dd = fmaxf(fabsf(den), tab[128 + tid]);
            if (tid < Lvalid) A_WS(float, WS_DEN)[(size_t)(rowc + tid) * MLH + h] = dd; }
#pragma unroll
        for (int dd2 = 0; dd2 < 2; ++dd2) { const int dt = 2 * w + dd2; float an = 0.f;
#pragma unroll
            for (int sb = 0; sb < 4; ++sb) { const s16x4 kv = tr16(L + ML_KS + (16 * sb + 4 * g + (i16 >> 2)) * ML_LD + (16 * dt + 4 * (i16 & 3)) * 2); const f32x4 w4 = *(const LAS f32x4*)(tab + 16 * sb + 4 * g);
                an += (__uint_as_float((unsigned)(unsigned short)kv[0] << 16) * w4[0] + __uint_as_float((unsigned)(unsigned short)kv[1] << 16) * w4[1]) + (__uint_as_float((unsigned)(unsigned short)kv[2] << 16) * w4[2] + __uint_as_float((unsigned)(unsigned short)kv[3] << 16) * w4[3]); }
            an += __shfl_xor(an, 16); an += __shfl_xor(an, 32);
            if (g == 0) nvec[16 * dt + i16] = wprev * nvec[16 * dt + i16] + an; } }
        __syncthreads();
    }
#undef ML_PREFETCH
    float* oc = A_OUT + (samp ? OUT_MLC_S : OUT_MLC_P) + ((size_t)(seq * MLH + h) * MLV + vbase + 16 * (w & 3) + i16) * MLQK + 4 * g;
    if (vw && doval) {
#pragma unroll
    for (int dt = 0; dt < 16; ++dt) *(f32x4*)(oc + 16 * dt) = C[dt]; }
    if (doden) { if (tid < MLQK) A_OUT[(samp ? OUT_MLN_S : OUT_MLN_P) + (seq * MLH + h) * MLQK + tid] = nvec[tid]; if (tid == 0) A_OUT[(samp ? OUT_MLM_S : OUT_MLM_P) + seq * MLH + h] = m; }
    __syncthreads();
}

__device__ __forceinline__ void ml_post(Frame& F) {
    const int gw = F.vcu * NWAVES + F.wave, NGW = F.G * NWAVES;
    for (int it0 = gw; it0 < M * MLH; it0 += 4 * NGW) {
        f32x4 a[4], b[4]; float dn[4]; v4u ow[4];
#pragma unroll
        for (int k = 0; k < 4; ++k) { int it = it0 + k * NGW; it = it < M * MLH ? it : it0; const int row = it >> 2, h = it & 3;
            const float* np = A_WS(float, WS_NUM) + (size_t)row * 2048 + h * MLV + 8 * F.lane; a[k] = *(const f32x4*)np; b[k] = *(const f32x4*)(np + 4);
            dn[k] = A_WS(float, WS_DEN)[(size_t)row * MLH + h]; ow[k] = *(const v4u*)(A_WS(bf16, WS_MO) + (size_t)row * 2048 + h * MLV + 8 * F.lane); }
#pragma unroll
        for (int k = 0; k < 4; ++k) { const int it = it0 + k * NGW; if (it >= M * MLH) continue; const int row = it >> 2, h = it & 3;
            const float dinv = 1.0f / dn[k];
            float hv[8] = {a[k][0] * dinv, a[k][1] * dinv, a[k][2] * dinv, a[k][3] * dinv, b[k][0] * dinv, b[k][1] * dinv, b[k][2] * dinv, b[k][3] * dinv};
            float ss = 0.f;
#pragma unroll
            for (int e = 0; e < 8; ++e) ss += hv[e] * hv[e];
            ss = wave_sum(ss);
            const float rinv = rsqrtf(ss * (1.0f / MLV) + EPS);
            const float* gp = A_IN(17) + h * MLV + 8 * F.lane; const f32x4 g0 = *(const f32x4*)gp, g1 = *(const f32x4*)(gp + 4);
            const float ov[8] = {bf_lo(ow[k].x), bf_hi(ow[k].x), bf_lo(ow[k].y), bf_hi(ow[k].y), bf_lo(ow[k].z), bf_hi(ow[k].z), bf_lo(ow[k].w), bf_hi(ow[k].w)};
            const float gv[8] = {g0[0], g0[1], g0[2], g0[3], g1[0], g1[1], g1[2], g1[3]};
            float y[8];
#pragma unroll
            for (int e = 0; e < 8; ++e) y[e] = hv[e] * rinv * gv[e] / (1.0f + __expf(-ov[e]));
            v4u wv; wv.x = cvtpk(y[0], y[1]); wv.y = cvtpk(y[2], y[3]); wv.z = cvtpk(y[4], y[5]); wv.w = cvtpk(y[6], y[7]);
            *(v4u*)(A_WS(bf16, WS_MIX) + (size_t)row * LDX + 2048 + h * MLV + 8 * F.lane) = wv; } }
}
__device__ __forceinline__ void final_norm(Frame& F) {
    const int gw = F.vcu * NWAVES + F.wave, NGW = F.G * NWAVES;
    for (int row = gw; row < M; row += NGW) { const float rs = pg8::rs_of(A_SSQ(4), row); const v4u* xr = (const v4u*)(A_WS(bf16, WS_XB) + (size_t)row * D) + F.lane; f32x4* yr = (f32x4*)(A_XF + (size_t)row * D) + 2 * F.lane; const f32x4* gr = (const f32x4*)A_IN(26) + 2 * F.lane;
#pragma unroll
        for (int j = 0; j < 8; ++j) { const v4u v = xr[64 * j]; const f32x4 g0 = gr[128 * j], g1 = gr[128 * j + 1];
            __builtin_nontemporal_store((f32x4){bf_lo(v.x), bf_hi(v.x), bf_lo(v.y), bf_hi(v.y)} * rs * g0, yr + 128 * j); __builtin_nontemporal_store((f32x4){bf_lo(v.z), bf_hi(v.z), bf_lo(v.w), bf_hi(v.w)} * rs * g1, yr + 128 * j + 1); } }
}

__global__ void __launch_bounds__(NWAVES * 64, 2) hsm_fwd(Args args) {
    extern __shared__ __attribute__((aligned(16))) unsigned char lds[];
    Frame F;
    F.lds = (LAS unsigned char*)lds; F.MISC = (volatile LAS unsigned*)(F.lds + MISC_OFF);
    F.tid = threadIdx.x; F.lane = F.tid & 63; F.wave = __builtin_amdgcn_readfirstlane(F.tid >> 6);
    F.G = gridDim.x; { const int bx = blockIdx.x; F.vcu = (F.G % 8 == 0) ? (bx % 8) * (F.G / 8) + bx / 8 : bx; }
    unsigned char* ws = args.ws; F.a = &args;
    for (int u = F.tid; u < 64; u += NWAVES * 64) ((LAS unsigned*)(F.lds + MISC_OFF))[u] = 0u;
    __syncthreads();
    XcdBarrier bar; bar.bar = (unsigned*)(ws + CTL_BAR_BYTE); bar.x = 0; bar.st = nullptr;
    if (MK_N_LAUNCHES == 1) bar = xcd_barrier_post((unsigned*)(ws + CTL_BAR_BYTE), F.MISC + 8);
    const int lo = args.ph_lo, hi = args.ph_hi;
#ifndef PH_MASK
#define PH_MASK 0x7ff
#endif
#define IN(k) (((PH_MASK >> (k)) & 1) && lo <= (k) && (k) < hi)
#define SEAM(k) do { if (IN(k) && IN((k) + 1)) xcd_barrier(bar); } while (0)
    const int bx = (int)blockIdx.x;

    if (IN(0)) { p0_prologue(F); } SEAM(0);
    if (IN(1)) {
        { pg8::Gemm g{A_WS(bf16, WS_XB), A_WS(bf16, WS_W1GU), M, NGU, D, LDX}; pg8::SplitOrder S; S.init(M, NGU, D, F.G, bx, F.a->ws + WS_SLAB, (unsigned*)(F.a->ws + CTL_CNT_BYTE) + 0 * 512 * 32); pg8::EpiGateUp<false, false> E{F.a->ws, WS_HB, 0}; pg8::gemm_phase<pg8::EpiGateUp<false, false>, pg8::SplitOrder, true, true>(F.lds, g, S, E); }
    } SEAM(1);
    if (IN(2)) { pg8::Gemm g{A_WS(bf16, WS_HB), A_WS(bf16, WS_W1D), M, D, FFN, LDH}; pg8::SplitOrder S; S.init(M, D, FFN, F.G, bx, F.a->ws + WS_SLAB, (unsigned*)(F.a->ws + CTL_CNT_BYTE) + 1 * 512 * 32); pg8::EpiResid<false, true> E{nullptr, nullptr, F.a->ws, 0.5f, 1};
        pg8::gemm_phase<pg8::EpiResid<false, true>, pg8::SplitOrder, true, true>(F.lds, g, S, E); } SEAM(2);
    if (IN(3)) { gates_rows(F);
        pg8::Gemm g{A_WS(bf16, WS_XB), A_WS(bf16, WS_WIN), M, NIN, D, LDX}; pg8::SplitOrder S; S.init(M, NIN, D, F.G, bx, F.a->ws + WS_SLAB, (unsigned*)(F.a->ws + CTL_CNT_BYTE) + 2 * 512 * 32);
        pg8::EpiWin E{F.a->ws, A_OUT};
        pg8::gemm_phase<pg8::EpiWin, pg8::SplitOrder, true, true>(F.lds, g, S, E); } SEAM(3);
    if (IN(4)) {
        if (bx < 72) { const bool dn = bx >= 64; const int sh = dn ? bx - 64 : (bx & 7);
            mlstm_scan(F, sh >> 2, sh & 3, dn ? 0 : (bx >> 3), false, !dn, dn); }
        else { const int j = bx - 72, nb = F.G - 72;
            { pg8::Gemm g{A_WS(bf16, WS_PB), A_WS(bf16, WS_WPP), M, D, PLE, PLE}; pg8::SplitOrder S; S.init(M, D, PLE, nb, j, F.a->ws + WS_SLAB, (unsigned*)(F.a->ws + CTL_CNT_BYTE) + 3 * 512 * 32); pg8::EpiPlain E{A_WS(bf16, WS_PP), D}; pg8::gemm_phase<pg8::EpiPlain, pg8::SplitOrder, true, true>(F.lds, g, S, E); }
            __syncthreads();
            for (int su = j; su < DBATCH * MLH * 8; su += nb) mlstm_scan(F, su >> 5, (su >> 3) & 3, su & 7, true, true, (su & 7) == 0);
            const int nw = nb * NWAVES;
            __syncthreads();
            if (F.wave < 4) { for (int u = j * NWAVES + F.wave; u < (M / 16) * SBH; u += nw) sb_unit(F, u, F.lds + F.wave * SB_VBYTES); p0_late_weights(F, j * NWAVES + F.wave, nw); p0_ple_weights(F, j * NWAVES + F.wave, nw); }
            else { p0_late_weights(F, j * NWAVES + F.wave, nw); p0_ple_weights(F, j * NWAVES + F.wave, nw); for (int u = j * NWAVES + F.wave; u < (M / 16) * SBH; u += nw) sb_unit(F, u, F.lds + F.wave * SB_VBYTES); } }
    } SEAM(4);
    if (IN(5)) { ml_post(F); } SEAM(5);
    if (IN(6)) { pg8::Gemm g{A_WS(bf16, WS_MIX), A_WS(bf16, WS_WOUT), M, D, D, LDX}; pg8::SplitOrder S; S.init(M, D, D, F.G, bx, F.a->ws + WS_SLAB, (unsigned*)(F.a->ws + CTL_CNT_BYTE) + 4 * 512 * 32); pg8::EpiResid<true, true> E{nullptr, nullptr, F.a->ws, 1.0f, 2};
        pg8::gemm_phase<pg8::EpiResid<true, true>, pg8::SplitOrder, true, true>(F.lds, g, S, E); } SEAM(6);
    if (IN(7)) { pg8::Gemm g{A_WS(bf16, WS_XB8), A_WS(bf16, WS_W2GU), M, NGU, D / 2, D / 2}; pg8::SplitOrder S; S.init(M, NGU, D / 2, F.G, bx, F.a->ws + WS_SLAB, (unsigned*)(F.a->ws + CTL_CNT_BYTE) + 5 * 512 * 32); pg8::EpiGateUp<true, true> E{F.a->ws, WS_HB, 2};
        pg8::gemm_phase<pg8::EpiGateUp<true, true>, pg8::SplitOrder, true, true, true>(F.lds, g, S, E); } SEAM(7);
    if (IN(8)) { pg8::Gemm g{A_WS(bf16, WS_HB), A_WS(bf16, WS_W2D), M, D, FFN / 2, FFN / 2}; pg8::SplitOrder S; S.init(M, D, FFN / 2, F.G, bx, F.a->ws + WS_SLAB, (unsigned*)(F.a->ws + CTL_CNT_BYTE) + 6 * 512 * 32); pg8::EpiResid<true, true> E{nullptr, nullptr, F.a->ws, 0.5f / 64.f, 3};
        pg8::gemm_phase<pg8::EpiResid<true, true>, pg8::SplitOrder, true, true, true>(F.lds, g, S, E); } SEAM(8);
    if (IN(9)) { pg8::Gemm g{A_WS(bf16, WS_XB8), A_WS(bf16, WS_WPG), M, D, D / 2, D / 2}; pg8::SplitOrder S; S.init(M, D, D / 2, F.G, bx, F.a->ws + WS_SLAB, (unsigned*)(F.a->ws + CTL_CNT_BYTE) + 7 * 512 * 32); pg8::EpiPle E{F.a->ws, 1.0f / 64.f};
        pg8::gemm_phase<pg8::EpiPle, pg8::SplitOrder, true, true, true>(F.lds, g, S, E); } SEAM(9);
    if (IN(10)) { final_norm(F); }
#undef IN
#undef SEAM
}

extern "C" void kernel_launch(void* const* d_in, const int* in_sizes, int n_in, void* d_out, int out_size, void* d_ws, size_t ws_size, hipStream_t stream) {
    static int grid = 0;
    if (grid == 0) {
        if (n_in != 27 || out_size != (int)OUT_END || ws_size < WS_END) { fprintf(stderr, "kernel_launch: unexpected shapes (n_in %d, out %d, ws %zu; need ws >= %zu)\n", n_in, out_size, ws_size, (size_t)WS_END); grid = -1; return; }
        int dev = 0, cus = 0, per_cu = 0;
        if (hipGetDevice(&dev) != hipSuccess || hipDeviceGetAttribute(&cus, hipDeviceAttributeMultiprocessorCount, dev) != hipSuccess) { grid = -1; return; }
        if (hipFuncSetAttribute((const void*)hsm_fwd, hipFuncAttributeMaxDynamicSharedMemorySize, LDS_BYTES) != hipSuccess) { fprintf(stderr, "kernel_launch: hipFuncSetAttribute failed\n"); grid = -1; return; }
        if (hipOccupancyMaxActiveBlocksPerMultiprocessor(&per_cu, (const void*)hsm_fwd, NWAVES * 64, LDS_BYTES) != hipSuccess || per_cu < 1) fprintf(stderr, "kernel_launch: occupancy query says %d\n", per_cu);
        (void)hipGetLastError();
        grid = cus;
    }
    if (grid < 0) return;
    if (hipMemsetAsync((char*)d_ws + WS_CTL, 0, CTL_ZERO_BYTES, stream) != hipSuccess) return;
    Args a{};
    for (int i = 0; i < 27; ++i) a.in[i] = (const float*)d_in[i];
    a.out = (float*)d_out; a.ws = (unsigned char*)d_ws;
#if MK_N_LAUNCHES == 1
    a.ph_lo = 0; a.ph_hi = N_PHASES;
    hipLaunchKernelGGL(hsm_fwd, dim3(grid), dim3(NWAVES * 64), LDS_BYTES, stream, a);
#else
    for (int p = 0; p < N_PHASES; ++p) { a.ph_lo = p; a.ph_hi = p + 1; hipLaunchKernelGGL(hsm_fwd, dim3(grid), dim3(NWAVES * 64), LDS_BYTES, stream, a); }
#endif
}
```

```cpp
#include <hip/hip_runtime.h>
#include <cstdio>
#include <cstdint>

constexpr int NWAVES = 8;
constexpr int D = 4096, MP = 8192, MS = 256, M = MP + MS, FFN = 11008, NGU = 2 * FFN, NIN = 12288, NINF = 12296;
constexpr int SBW = 2048, SBH = 16, SBD = 128, MLH = 4, MLQK = 256, MLV = 512, PLE = 256, SEQ = 4096, PAST = 4096, DSEQ = 32, DBATCH = 8, CHUNK = 64;
constexpr float EPS = 1e-6f;
constexpr int LDX = D, LDH = FFN;
#ifndef MK_N_LAUNCHES
#define MK_N_LAUNCHES 1
#endif
constexpr int N_PHASES = 11;
constexpr size_t OUT_Y = 0, OUT_SBK_P = (size_t)M * D, OUT_SBV_P = OUT_SBK_P + (size_t)MP * SBW, OUT_MLC_P = OUT_SBV_P + (size_t)MP * SBW, OUT_MLN_P = OUT_MLC_P + (size_t)2 * MLH * MLV * MLQK,
    OUT_MLM_P = OUT_MLN_P + 2 * MLH * MLQK, OUT_SBK_S = OUT_MLM_P + 2 * MLH, OUT_SBV_S = OUT_SBK_S + (size_t)MS * SBW, OUT_MLC_S = OUT_SBV_S + (size_t)MS * SBW,
    OUT_MLN_S = OUT_MLC_S + (size_t)DBATCH * MLH * MLV * MLQK, OUT_MLM_S = OUT_MLN_S + DBATCH * MLH * MLQK, OUT_END = OUT_MLM_S + DBATCH * MLH;
static_assert(OUT_END == 74459176, "output size");
constexpr size_t MiB = 1u << 20;
constexpr size_t al(size_t x) { return (x + MiB - 1) / MiB * MiB; }
constexpr size_t WS_CTL = 0, CTL_ZERO_BYTES = 2 * MiB;
constexpr size_t CTL_BAR_BYTE = 16384;
constexpr size_t CTL_SSQ_BYTE = 65536;
constexpr size_t WS_W1GU = 2 * MiB, WS_W1D = WS_W1GU + al((size_t)NGU * LDX * 2), WS_WIN = WS_W1D + al((size_t)D * LDH * 2), WS_WOUT = WS_WIN + al((size_t)NIN * LDX * 2),
    WS_W2GU = WS_WOUT + al((size_t)D * LDX * 2), WS_W2D = WS_W2GU + al((size_t)NGU * LDX * 2), WS_WPG = WS_W2D + al((size_t)D * LDH * 2), WS_WPP = WS_WPG + al((size_t)D * LDX * 2),
    WS_WIF = WS_WPP + al((size_t)D * PLE * 2), WS_XB = WS_WIF + al((size_t)8 * D * 4), WS_HB = WS_XB + al((size_t)M * LDX * 2), WS_QB = WS_HB + al((size_t)M * LDH * 2),
    WS_KB = WS_QB + al((size_t)M * SBW * 2), WS_VB = WS_KB + al((size_t)M * SBW * 2), WS_MQ = WS_VB + al((size_t)M * SBW * 2), WS_MK = WS_MQ + al((size_t)M * 1024 * 2),
    WS_MV = WS_MK + al((size_t)M * 1024 * 2), WS_MO = WS_MV + al((size_t)M * 2048 * 2), WS_GATES = WS_MO + al((size_t)M * 2048 * 2), WS_MIX = WS_GATES + al((size_t)M * 8 * 4),
    WS_PP = WS_MIX + al((size_t)M * LDX * 2), WS_PB = WS_PP + al((size_t)M * D * 2), WS_NUM = WS_PB + al((size_t)M * PLE * 2), WS_DEN = WS_NUM + al((size_t)M * 2048 * 4),
    WS_MLS = WS_DEN + al((size_t)M * 4 * 4), WS_XB8 = WS_MLS + al((size_t)256 * 21504 * 4)  , WS_SLAB = WS_XB8 + al((size_t)M * D)  , WS_END = WS_SLAB + (size_t)256 * 262144;
constexpr size_t CTL_CNT_BYTE = 1 * MiB;
static_assert(CTL_SSQ_BYTE + 6 * (size_t)M * 8 <= CTL_CNT_BYTE && CTL_CNT_BYTE + 8 * 512 * 128 <= CTL_ZERO_BYTES, "ctl");
constexpr int LDS_BYTES = 163840;
constexpr int MISC_OFF = 163840 - 256;

namespace pg8 {
#define PG8_LAS __attribute__((address_space(3)))
typedef unsigned short bf16_t;
typedef short bf16x8 __attribute__((ext_vector_type(8)));
typedef float f32x4 __attribute__((ext_vector_type(4)));
typedef unsigned u32x4 __attribute__((ext_vector_type(4)));
typedef int v8i __attribute__((ext_vector_type(8)));
constexpr int BM = 256, BK = 64, HALF = 128, HTB = HALF * BK * 2  , STAGE_BYTES = 8 * HTB, NXCD = 8, WGM = 8;

__host__ __device__ __forceinline__ int lds_byte(int r, int c) { const int st = (r >> 4) * 2 + (c >> 5), rr = r & 15, cc = c & 31, ob = rr * 64 + cc * 2; return st * 1024 + (ob ^ (((ob >> 9) & 1) << 5)); }
__host__ __device__ __forceinline__ void stage_rc(int b, int& R, int& C) { const int st = b / 1024, sb = b % 1024, swz = sb ^ (((sb >> 9) & 1) << 5); R = (st >> 1) * 16 + swz / 64; C = (st & 1) * 32 + (swz % 64) / 2; }
__host__ __device__ __forceinline__ int perm32(int rho) { const int n = rho >> 4, i = rho & 15; return 8 * (i >> 2) + 4 * n + (i & 3); }

struct Unit { int pm, pn, k0, nk, split, S, s, tile, xw, rx, ix; };
constexpr int SLAB_BYTES = 256 * 256 * 4;
struct Gemm { const bf16_t* A; const bf16_t* Bt; int M, N, K, ld; };

struct StaticOrder {
    int nM, nN, nwg, G, c;
    __host__ __device__ void init(int M, int N, int G_, int c_) { nM = M / BM; nN = N / BM; nwg = nM * nN; G = G_; c = c_; }
    __host__ __device__ bool next(int i, Unit& u) const {
        const long L = (long)i * G + c; if (L >= nwg) return false;
        int wgid = (int)L; { const int q = nwg / NXCD, r = nwg % NXCD, xcd = wgid % NXCD, off = wgid / NXCD; wgid = (xcd < r ? xcd * (q + 1) : r * (q + 1) + (xcd - r) * q) + off; }
        const int nig = WGM * nN, gid = wgid / nig, fm = gid * WGM, gsz = (nM - fm) < WGM ? (nM - fm) : WGM;
        u.pm = fm + ((wgid % nig) % gsz); u.pn = (wgid % nig) / gsz; return true;
    }
    __device__ __forceinline__ void a_ready(const Unit&) const {}
    __device__ __forceinline__ void done(const Unit&) const {}
};
typedef float f32x2_t __attribute__((ext_vector_type(2)));
typedef __bf16 bf16x2_t __attribute__((ext_vector_type(2)));
typedef unsigned u32x2 __attribute__((ext_vector_type(2)));
__device__ __forceinline__ unsigned cvtpk(float lo, float hi) { f32x2_t v = {lo, hi}; bf16x2_t b = __builtin_convertvector(v, bf16x2_t); return __builtin_bit_cast(unsigned, b); }
template <class T> __device__ __forceinline__ T* opq(T* p) { const unsigned long long v = (unsigned long long)p; unsigned lo = __builtin_amdgcn_readfirstlane((unsigned)v), hi = __builtin_amdgcn_readfirstlane((unsigned)(v >> 32));
    asm volatile("" : "+s"(lo), "+s"(hi)); return (T*)(((unsigned long long)hi << 32) | lo); }
__device__ __forceinline__ float opqf(float x) { unsigned v = __builtin_amdgcn_readfirstlane(__float_as_uint(x)); asm volatile("" : "+s"(v)); return __uint_as_float(v); }
constexpr int DM = 4096, DFF = 11008, MPROMPT = 8192;
constexpr float SSQ_SCALE = 16777216.0f;
__device__ __forceinline__ float rs_of(const unsigned long long* ssq, int row) { return rsqrtf((float)ssq[row] * (1.0f / (16777216.0f * 4096.0f)) + 1e-6f); }
__device__ __forceinline__ unsigned pack4_fp8(float a, float b, float c, float d) { int w = __builtin_amdgcn_cvt_pk_fp8_f32(a, b, 0, false); w = __builtin_amdgcn_cvt_pk_fp8_f32(c, d, w, true); return (unsigned)w; }
__device__ __forceinline__ unsigned long long ssq_fix(float s) { return (unsigned long long)(s * SSQ_SCALE + 0.5f); }


struct SplitOrder {
    int nM, nN, nwg, G, c, ntk, Rf, r, split_ok; unsigned char* slab; unsigned* cnt;
    __device__ __forceinline__ void init(int M, int N, int K, int G_, int c_, unsigned char* slab_, unsigned* cnt_) { nM = M / BM; nN = N / BM; nwg = nM * nN; G = __builtin_amdgcn_readfirstlane(G_); c = __builtin_amdgcn_readfirstlane(c_); ntk = K / BK;
        Rf = __builtin_amdgcn_readfirstlane(nwg / G); r = nwg - Rf * G; slab = slab_; cnt = cnt_; split_ok = (G % 8 == 0) && (G >= 64) && (ntk >= 8) && (ntk % 2 == 0); }
    __device__ __forceinline__ void map(int L, Unit& u) const {
        int wgid = L; { const int q = nwg / NXCD, r8 = nwg % NXCD, xcd = wgid % NXCD, off = wgid / NXCD; wgid = (xcd < r8 ? xcd * (q + 1) : r8 * (q + 1) + (xcd - r8) * q) + off; }
        const int nig = WGM * nN, gid = wgid / nig, fm = gid * WGM, gsz = (nM - fm) < WGM ? (nM - fm) : WGM;
        u.pm = __builtin_amdgcn_readfirstlane(fm + ((wgid % nig) % gsz)); u.pn = __builtin_amdgcn_readfirstlane((wgid % nig) / gsz); }
    __device__ __forceinline__ bool next(int i, Unit& u) const {
        u.k0 = 0; u.nk = ntk; u.split = 0; u.S = 1; u.s = 0; u.tile = 0; u.xw = 0; u.rx = 1; u.ix = i;
        if (i < Rf) { map(i * G + c, u); return true; }
        if (i > Rf || r == 0) return false;
        if (!split_ok) { if (c >= r) return false; map(Rf * G + c, u); return true; }
        const int x = c & 7, w = c >> 3, W = G >> 3, rx = (x < r) ? (r - x + 7) / 8 : 0;
        if (rx == 0) return false;
        const int s = __builtin_amdgcn_readfirstlane(w / rx), tp = w - s * rx; int S = __builtin_amdgcn_readfirstlane((W - tp + rx - 1) / rx); const int np = ntk / 2; if (S > np / 2) S = np / 2;
        if (s >= S) return false;
        const int j = x + 8 * tp; map(Rf * G + j, u);
        const int p0 = __builtin_amdgcn_readfirstlane((s * np) / S), p1 = __builtin_amdgcn_readfirstlane(((s + 1) * np) / S);
        u.k0 = 2 * p0; u.nk = 2 * (p1 - p0); u.split = (S > 1) ? 1 : 0; u.S = S; u.s = s; u.tile = j; u.xw = x + 8 * tp; u.rx = rx; return true; }
    __device__ __forceinline__ void a_ready(const Unit&) const {}
    __device__ __forceinline__ void done(const Unit&) const {}
};

#define PG8_RSC(u_, r_) (((const PG8_LAS float*)(unsigned)131072u)[(u_).ix * 256 + (r_)])
template <bool W8, bool H8> struct EpiGateUp {
    static constexpr bool PERM = false, AFTER_DRAIN = false, RSC = true;
    __device__ __forceinline__ const unsigned long long* rs_src() const { return (const unsigned long long*)(ws + CTL_SSQ_BYTE) + (size_t)ssq_k * 8448; }
    unsigned char* ws; size_t h_off; int ssq_k;
    __device__ __forceinline__ void operator()(const f32x4 (&acc)[2][2][4][2], const Unit& u, int wr, int wc, int fr, int fq, unsigned mask) const {
        const int row0 = u.pm * BM + wr * 64 + fr, col0 = u.pn * 128 + wc * 16 + 4 * fq; unsigned char* const wsp = opq(this->ws); bf16_t* const H = (bf16_t*)(wsp + h_off); const unsigned long long* const ssq = (const unsigned long long*)(wsp + CTL_SSQ_BYTE) + (size_t)ssq_k * 8448;
#pragma unroll
        for (int ai = 0; ai < 2; ++ai)
#pragma unroll
            for (int m = 0; m < 4; ++m) { if (!((mask >> ((ai * 4 + m) * 2)) & 3u)) continue; const int row = row0 + ai * HALF + m * 16; const float rs = PG8_RSC(u, wr * 64 + fr + ai * HALF + m * 16) * (W8 ? 0.015625f : 1.0f); bf16_t* rowp = H + (size_t)row * LDH + col0;
#pragma unroll
                for (int bj = 0; bj < 2; ++bj) { if (!((mask >> ((ai * 4 + m) * 2 + bj)) & 1u)) continue; const f32x4 g = acc[ai][bj][m][0] * rs, up = acc[ai][bj][m][1] * rs; f32x4 h;
#pragma unroll
                    for (int e = 0; e < 4; ++e) h[e] = g[e] * __builtin_amdgcn_rcpf(1.0f + __expf(-g[e])) * up[e];
                    if constexpr (H8) *(unsigned*)((unsigned char*)H + (size_t)row * DFF + col0 + bj * 64) = pack4_fp8(h[0], h[1], h[2], h[3]);
                    else { u32x2 w; w.x = cvtpk(h[0], h[1]); w.y = cvtpk(h[2], h[3]); *(u32x2*)(rowp + bj * 64) = w; } } }
    }
};
template <bool OUT8, bool RESB> struct EpiResid {
    static constexpr bool PERM = true, AFTER_DRAIN = false, RSC = false;
    const float* res_p; const float* res_s; unsigned char* ws; float alpha; int ssq_k;
    __device__ __forceinline__ void operator()(const f32x4 (&acc)[2][2][4][2], const Unit& u, int wr, int wc, int fr, int fq, unsigned mask) const {
        const int row0 = u.pm * BM + wr * 64 + fr, col0 = u.pn * BM + wc * 32 + 8 * fq;
        const float* src = RESB ? nullptr : opq((u.pm < 32) ? res_p : (res_s - (size_t)MPROMPT * DM)); unsigned char* const wsp = opq(this->ws); bf16_t* const XB = (bf16_t*)(wsp + WS_XB); unsigned long long* const ssq_out = (unsigned long long*)(wsp + CTL_SSQ_BYTE) + (size_t)ssq_k * 8448; const float alpha = opqf(this->alpha);
#pragma unroll
        for (int ai = 0; ai < 2; ++ai)
#pragma unroll
            for (int m = 0; m < 4; ++m) { if (!((mask >> ((ai * 4 + m) * 2)) & 3u)) continue; const int row = row0 + ai * HALF + m * 16; const size_t off = (size_t)row * DM + col0; float ss = 0.f;
#pragma unroll
                for (int bj = 0; bj < 2; ++bj) { if (!((mask >> ((ai * 4 + m) * 2 + bj)) & 1u)) continue; bf16_t* const xb = XB + (size_t)row * LDX + col0 + bj * HALF; f32x4 r0, r1;
                    if constexpr (RESB) { const u32x4 rw = *(const u32x4*)xb; r0[0] = __uint_as_float(rw.x << 16); r0[1] = __uint_as_float(rw.x & 0xffff0000u); r0[2] = __uint_as_float(rw.y << 16); r0[3] = __uint_as_float(rw.y & 0xffff0000u);
                        r1[0] = __uint_as_float(rw.z << 16); r1[1] = __uint_as_float(rw.z & 0xffff0000u); r1[2] = __uint_as_float(rw.w << 16); r1[3] = __uint_as_float(rw.w & 0xffff0000u); }
                    else { r0 = *(const f32x4*)(src + off + bj * HALF); r1 = *(const f32x4*)(src + off + bj * HALF + 4); }
                    const f32x4 o0 = r0 + acc[ai][bj][m][0] * alpha, o1 = r1 + acc[ai][bj][m][1] * alpha;
                    { u32x4 w; w.x = cvtpk(o0[0], o0[1]); w.y = cvtpk(o0[2], o0[3]); w.z = cvtpk(o1[0], o1[1]); w.w = cvtpk(o1[2], o1[3]); *(u32x4*)xb = w; }
                    if constexpr (OUT8) { u32x2 q; q.x = pack4_fp8(o0[0], o0[1], o0[2], o0[3]); q.y = pack4_fp8(o1[0], o1[1], o1[2], o1[3]); *(u32x2*)(wsp + WS_XB8 + (size_t)row * DM + col0 + bj * HALF) = q; }
                    ss += ((o0[0] * o0[0] + o0[1] * o0[1]) + (o0[2] * o0[2] + o0[3] * o0[3])) + ((o1[0] * o1[0] + o1[1] * o1[1]) + (o1[2] * o1[2] + o1[3] * o1[3])); }
                ss += __shfl_xor(ss, 16); ss += __shfl_xor(ss, 32);
                if (fq == 0) atomicAdd(ssq_out + row, ssq_fix(ss));
                if (m == 3) asm volatile("" ::: "memory"); }
    }
};
struct EpiPle {
    static constexpr bool PERM = true, AFTER_DRAIN = false, RSC = true;
    __device__ __forceinline__ const unsigned long long* rs_src() const { return (const unsigned long long*)(ws + CTL_SSQ_BYTE) + (size_t)3 * 8448; }
    unsigned char* ws; float zscale;
    __device__ __forceinline__ void operator()(const f32x4 (&acc)[2][2][4][2], const Unit& u, int wr, int wc, int fr, int fq, unsigned mask) const {
        const int row0 = u.pm * BM + wr * 64 + fr, col0 = u.pn * BM + wc * 32 + 8 * fq;
        unsigned char* const wsp = opq(this->ws); const float zscale = opqf(this->zscale); const bf16_t* const PP = (const bf16_t*)(wsp + WS_PP); bf16_t* const XB = (bf16_t*)(wsp + WS_XB); const unsigned long long* const ssq = (const unsigned long long*)(wsp + CTL_SSQ_BYTE) + (size_t)3 * 8448; unsigned long long* const ssq_out = (unsigned long long*)(wsp + CTL_SSQ_BYTE) + (size_t)4 * 8448;
#pragma unroll
        for (int ai = 0; ai < 2; ++ai)
#pragma unroll
            for (int m = 0; m < 4; ++m) { if (!((mask >> ((ai * 4 + m) * 2)) & 3u)) continue; const int row = row0 + ai * HALF + m * 16; const size_t off = (size_t)row * DM + col0; const float rs = PG8_RSC(u, wr * 64 + fr + ai * HALF + m * 16) * zscale; float ss = 0.f;
#pragma unroll
                for (int bj = 0; bj < 2; ++bj) { if (!((mask >> ((ai * 4 + m) * 2 + bj)) & 1u)) continue; bf16_t* const xb = XB + (size_t)row * LDX + col0 + bj * HALF;
                    const u32x4 xw = *(const u32x4*)xb; const u32x4 pw = *(const u32x4*)(PP + off + bj * HALF);
                    const unsigned xs[4] = {xw.x, xw.y, xw.z, xw.w}, ps[4] = {pw.x, pw.y, pw.z, pw.w}; unsigned ow[4];
#pragma unroll
                    for (int n = 0; n < 2; ++n) { const f32x4 z = acc[ai][bj][m][n] * rs;
#pragma unroll
                        for (int hh = 0; hh < 2; ++hh) { const unsigned xv = xs[2 * n + hh], pv = ps[2 * n + hh];
                            const float oa = __uint_as_float(xv << 16) + __builtin_amdgcn_rcpf(1.0f + __expf(-z[2 * hh])) * __uint_as_float(pv << 16);
                            const float ob = __uint_as_float(xv & 0xffff0000u) + __builtin_amdgcn_rcpf(1.0f + __expf(-z[2 * hh + 1])) * __uint_as_float(pv & 0xffff0000u);
                            ow[2 * n + hh] = cvtpk(oa, ob); ss += oa * oa + ob * ob; } }
                    { u32x4 w; w.x = ow[0]; w.y = ow[1]; w.z = ow[2]; w.w = ow[3]; *(u32x4*)xb = w; } }
                ss += __shfl_xor(ss, 16); ss += __shfl_xor(ss, 32);
                if (fq == 0) atomicAdd(ssq_out + row, ssq_fix(ss));
                if (m == 3) asm volatile("" ::: "memory"); }
    }
};
struct EpiPlain {
    static constexpr bool PERM = false, AFTER_DRAIN = false, RSC = false;
    bf16_t* O; int ldc;
    __device__ __forceinline__ void operator()(const f32x4 (&acc)[2][2][4][2], const Unit& u, int wr, int wc, int fr, int fq, unsigned mask) const {
        const int row0 = u.pm * BM + wr * 64 + fr, col0 = u.pn * BM + wc * 32 + 4 * fq;
#pragma unroll
        for (int ai = 0; ai < 2; ++ai)
#pragma unroll
            for (int m = 0; m < 4; ++m) { if (!((mask >> ((ai * 4 + m) * 2)) & 3u)) continue; bf16_t* rowp = opq(O) + (size_t)(row0 + ai * HALF + m * 16) * ldc + col0;
#pragma unroll
                for (int bj = 0; bj < 2; ++bj)
#pragma unroll
                    for (int n = 0; n < 2; ++n) { if (!((mask >> ((ai * 4 + m) * 2 + bj)) & 1u)) continue; const f32x4 v = acc[ai][bj][m][n]; u32x2 w; w.x = cvtpk(v[0], v[1]); w.y = cvtpk(v[2], v[3]); *(u32x2*)(rowp + bj * HALF + n * 16) = w; } }
    }
};
struct EpiWin {
    static constexpr bool PERM = true, AFTER_DRAIN = false, RSC = true;
    __device__ __forceinline__ const unsigned long long* rs_src() const { return (const unsigned long long*)(ws + CTL_SSQ_BYTE) + (size_t)1 * 8448; }
    unsigned char* ws; float* out;
    __device__ __forceinline__ void operator()(const f32x4 (&acc)[2][2][4][2], const Unit& u, int wr, int wc, int fr, int fq, unsigned mask) const {
        const int row0 = u.pm * BM + wr * 64 + fr; const int pn = u.pn;
        bf16_t* dst; int ld, cbase; float sc = 1.f; float* fdst = nullptr;
        unsigned char* const wsp = opq(this->ws); float* const outp = opq(this->out); size_t doff;
        if (pn < 8) { doff = WS_QB; ld = 2048; cbase = pn * 256; sc = 0.08838834764831845f; }
        else if (pn < 16) { doff = WS_KB; ld = 2048; cbase = (pn - 8) * 256; fdst = (u.pm < 32) ? outp + OUT_SBK_P : (outp + OUT_SBK_S - (size_t)MPROMPT * 2048); }
        else if (pn < 24) { doff = WS_VB; ld = 2048; cbase = (pn - 16) * 256; fdst = (u.pm < 32) ? outp + OUT_SBV_P : (outp + OUT_SBV_S - (size_t)MPROMPT * 2048); }
        else if (pn < 28) { doff = WS_MQ; ld = 1024; cbase = (pn - 24) * 256; sc = 0.0625f; }
        else if (pn < 32) { doff = WS_MK; ld = 1024; cbase = (pn - 28) * 256; }
        else if (pn < 40) { doff = WS_MV; ld = 2048; cbase = (pn - 32) * 256; }
        else { doff = WS_MO; ld = 2048; cbase = (pn - 40) * 256; }
        dst = (bf16_t*)(wsp + doff);
        const int col0 = cbase + wc * 32 + 8 * fq; const unsigned long long* const ssq = (const unsigned long long*)(wsp + CTL_SSQ_BYTE) + (size_t)1 * 8448;
#pragma unroll
        for (int ai = 0; ai < 2; ++ai)
#pragma unroll
            for (int m = 0; m < 4; ++m) { if (!((mask >> ((ai * 4 + m) * 2)) & 3u)) continue; const int row = row0 + ai * HALF + m * 16; const float rs = PG8_RSC(u, wr * 64 + fr + ai * HALF + m * 16) * sc; bf16_t* rowp = dst + (size_t)row * ld + col0;
#pragma unroll
                for (int bj = 0; bj < 2; ++bj) { if (!((mask >> ((ai * 4 + m) * 2 + bj)) & 1u)) continue; const f32x4 v0 = acc[ai][bj][m][0] * rs, v1 = acc[ai][bj][m][1] * rs;
                    u32x4 w; w.x = cvtpk(v0[0], v0[1]); w.y = cvtpk(v0[2], v0[3]); w.z = cvtpk(v1[0], v1[1]); w.w = cvtpk(v1[2], v1[3]);
                    *(u32x4*)(rowp + bj * HALF) = w;
                    if (fdst) { float* fp = fdst + (size_t)row * 2048 + col0 + bj * HALF; __builtin_nontemporal_store(v0, (f32x4*)fp); __builtin_nontemporal_store(v1, (f32x4*)(fp + 4)); } } }
    }
};

template <class Epi, class Sched, bool ALIGN_EPI = false, bool SP2 = false, bool F8 = false>
__device__ __forceinline__ void gemm_phase(PG8_LAS unsigned char* lds, const Gemm g, const Sched& S, const Epi& E) {
    const int tid = threadIdx.x, wid = __builtin_amdgcn_readfirstlane(tid >> 6), lane = tid & 63, wr = wid >> 2, wc = wid & 3, fr = lane & 15, fq = lane >> 4;
    const int K = g.K;
    unsigned voffA[2], voffB[2];
#pragma unroll
    for (int i = 0; i < 2; ++i) { int R, C; stage_rc(tid * 16 + i * 8192, R, C); const int Rb = Epi::PERM ? ((R & ~31) + perm32(R & 31)) : R;
        voffA[i] = (unsigned)(R * g.ld + C) * 2u; voffB[i] = (unsigned)(Rb * g.ld + C) * 2u; }
    const size_t kstep = (size_t)(BK * 2);
    const size_t hstep = (size_t)HALF * g.ld * 2;
    const size_t tstep = 2 * hstep;
    const unsigned ldsw = (unsigned)wid * 1024u;
    const int aoff = lds_byte(wr * 64 + fr, fq * 8), boff = lds_byte(wc * 32 + fr, fq * 8);
    const int aoff8a = lds_byte(wr * 64 + fr, fq * 16), aoff8b = lds_byte(wr * 64 + fr, fq * 16 + 8), boff8a = lds_byte(wc * 32 + fr, fq * 16), boff8b = lds_byte(wc * 32 + fr, fq * 16 + 8);
#define PG8_SA(b, h) (((b) * 2 + (h)) * HTB)
#define PG8_SB(b, h) ((4 + (b) * 2 + (h)) * HTB)
#define PG8_STAGE(bufoff, gbase, voff) do { _Pragma("unroll") for (int _i = 0; _i < 2; ++_i) \
        __builtin_amdgcn_global_load_lds((const unsigned*)((const char*)(gbase) + (voff)[_i]), (PG8_LAS unsigned*)(lds + (bufoff) + ldsw + _i * 8192), 16, 0, 0); } while (0)
#define PG8_LDA(dst, b, h) do { if constexpr (F8) { _Pragma("unroll") for (int m = 0; m < 4; ++m) { const u32x4 lo_ = *(const PG8_LAS u32x4*)(lds + PG8_SA(b, h) + aoff8a + m * 2048), hi_ = *(const PG8_LAS u32x4*)(lds + PG8_SA(b, h) + aoff8b + m * 2048); \
            dst##8[m] = (v8i){(int)lo_.x, (int)lo_.y, (int)lo_.z, (int)lo_.w, (int)hi_.x, (int)hi_.y, (int)hi_.z, (int)hi_.w}; } } \
        else { _Pragma("unroll") for (int m = 0; m < 4; ++m) _Pragma("unroll") for (int k = 0; k < 2; ++k) dst[m][k] = *(const PG8_LAS bf16x8*)(lds + PG8_SA(b, h) + aoff + m * 2048 + k * 1024); } } while (0)
#define PG8_LDB(dst, b, h) do { if constexpr (F8) { _Pragma("unroll") for (int n = 0; n < 2; ++n) { const u32x4 lo_ = *(const PG8_LAS u32x4*)(lds + PG8_SB(b, h) + boff8a + n * 2048), hi_ = *(const PG8_LAS u32x4*)(lds + PG8_SB(b, h) + boff8b + n * 2048); \
            dst##8[n] = (v8i){(int)lo_.x, (int)lo_.y, (int)lo_.z, (int)lo_.w, (int)hi_.x, (int)hi_.y, (int)hi_.z, (int)hi_.w}; } } \
        else { _Pragma("unroll") for (int n = 0; n < 2; ++n) _Pragma("unroll") for (int k = 0; k < 2; ++k) dst[n][k] = *(const PG8_LAS bf16x8*)(lds + PG8_SB(b, h) + boff + n * 2048 + k * 1024); } } while (0)
#define PG8_MMA(ai, bj, At, Bt) do { __builtin_amdgcn_s_setprio(1); \
        if constexpr (F8) { _Pragma("unroll") for (int m = 0; m < 4; ++m) _Pragma("unroll") for (int n = 0; n < 2; ++n) \
            asm volatile("v_mfma_f32_16x16x128_f8f6f4 %0, %1, %2, %0" : "+v"(acc[ai][bj][m][n]) : "v"(Bt##8[n]), "v"(At##8[m])); } \
        else { _Pragma("unroll") for (int m = 0; m < 4; ++m) _Pragma("unroll") for (int n = 0; n < 2; ++n) _Pragma("unroll") for (int k = 0; k < 2; ++k) \
            acc[ai][bj][m][n] = __builtin_amdgcn_mfma_f32_16x16x32_bf16(Bt[n][k], At[m][k], acc[ai][bj][m][n], 0, 0, 0); } __builtin_amdgcn_s_setprio(0); } while (0)
#define PG8_WAIT_V(n) asm volatile("s_waitcnt vmcnt(" #n ")" ::: "memory")
#define PG8_WAIT_L(n) asm volatile("s_waitcnt lgkmcnt(" #n ")" ::: "memory")
#define PG8_BAR __builtin_amdgcn_s_barrier()
#define PG8_SCHED __builtin_amdgcn_sched_barrier(0)
    Unit cur, nxt; int ui = 0;
    if (!S.next(0, cur)) return;
    if constexpr (Epi::RSC) {
        if (tid < 256) { const unsigned long long* sp = E.rs_src(); unsigned long long raw[13];
#pragma unroll
            for (int i = 0; i < 13; ++i) { Unit t; const bool ok = S.next(i, t); raw[i] = sp[(ok ? t.pm : 0) * BM + tid]; }
#pragma unroll
            for (int i = 0; i < 13; ++i) ((PG8_LAS float*)(lds + 131072))[i * 256 + tid] = rsqrtf((float)raw[i] * (1.0f / (16777216.0f * 4096.0f)) + 1e-6f); } }
    f32x4 acc[2][2][4][2];
#pragma unroll
    for (int a = 0; a < 2; ++a)
#pragma unroll
        for (int b = 0; b < 2; ++b)
#pragma unroll
            for (int m = 0; m < 4; ++m)
#pragma unroll
                for (int n = 0; n < 2; ++n) acc[a][b][m][n] = (f32x4){0.f, 0.f, 0.f, 0.f};
    bf16x8 At[4][2], B0[2][2], B1[2][2]; v8i At8[4], B08[2], B18[2];
    int sc127 = 127; asm volatile("" : "+v"(sc127));
    const char* cA = (const char*)g.A + (size_t)cur.pm * tstep + (size_t)cur.k0 * kstep; const char* cB = (const char*)g.Bt + (size_t)cur.pn * tstep + (size_t)cur.k0 * kstep;
    S.a_ready(cur);
    if constexpr (SP2) {
        PG8_STAGE(PG8_SB(0, 0), cB, voffB); PG8_STAGE(PG8_SB(0, 1), cB + hstep, voffB); PG8_STAGE(PG8_SA(0, 0), cA, voffA); PG8_STAGE(PG8_SA(0, 1), cA + hstep, voffA);
        if (wr == 1) PG8_BAR;
        PG8_WAIT_V(2); PG8_BAR;
        PG8_STAGE(PG8_SB(1, 0), cB + kstep, voffB); PG8_STAGE(PG8_SA(1, 0), cA + kstep, voffA); PG8_STAGE(PG8_SB(1, 1), cB + hstep + kstep, voffB);
        PG8_WAIT_V(6); PG8_BAR;
    } else {
        PG8_STAGE(PG8_SB(0, 0), cB, voffB); PG8_STAGE(PG8_SA(0, 0), cA, voffA); PG8_STAGE(PG8_SB(0, 1), cB + hstep, voffB); PG8_STAGE(PG8_SA(0, 1), cA + hstep, voffA);
        if (wr == 1) PG8_BAR;
        PG8_WAIT_V(4); PG8_BAR;
        PG8_STAGE(PG8_SB(1, 0), cB + kstep, voffB); PG8_STAGE(PG8_SA(1, 0), cA + kstep, voffA); PG8_STAGE(PG8_SB(1, 1), cB + hstep + kstep, voffB);
        PG8_WAIT_V(6); PG8_BAR;
    }
    for (;;) {
        const bool has_next = S.next(ui + 1, nxt);
        const char* nA = has_next ? (const char*)g.A + (size_t)nxt.pm * tstep + (size_t)nxt.k0 * kstep : cA; const char* nB = has_next ? (const char*)g.Bt + (size_t)nxt.pn * tstep + (size_t)nxt.k0 * kstep : cB;
        const int nt = cur.nk;
        for (int t = 0; t < nt; t += 2) {
            const bool last = (t == nt - 2);
            const char* a1 = cA + (size_t)(t + 1) * kstep;
            const char* a2 = last ? nA : cA + (size_t)(t + 2) * kstep; const char* b2 = last ? nB : cB + (size_t)(t + 2) * kstep;
            const char* a3 = a2 + kstep; const char* b3 = b2 + kstep;
            if (last && has_next) S.a_ready(nxt);
            if constexpr (SP2) {
            PG8_LDB(B0, 0, 0); PG8_LDB(B1, 0, 1); PG8_SCHED; PG8_LDA(At, 0, 0); PG8_STAGE(PG8_SA(1, 1), a1 + hstep, voffA);
            PG8_WAIT_V(8); PG8_WAIT_L(0); PG8_BAR; PG8_MMA(0, 0, At, B0); PG8_MMA(0, 1, At, B1); PG8_BAR; PG8_SCHED;
            PG8_LDA(At, 0, 1); PG8_STAGE(PG8_SB(0, 0), b2, voffB); PG8_STAGE(PG8_SB(0, 1), b2 + hstep, voffB); PG8_STAGE(PG8_SA(0, 0), a2, voffA);
            PG8_WAIT_V(8); PG8_WAIT_L(0); PG8_BAR; PG8_MMA(1, 0, At, B0); PG8_MMA(1, 1, At, B1); PG8_BAR; PG8_SCHED;
            PG8_LDB(B0, 1, 0); PG8_LDB(B1, 1, 1); PG8_SCHED; PG8_LDA(At, 1, 0); PG8_STAGE(PG8_SA(0, 1), a2 + hstep, voffA);
            PG8_WAIT_V(8); PG8_WAIT_L(0); PG8_BAR; PG8_MMA(0, 0, At, B0); PG8_MMA(0, 1, At, B1); PG8_BAR; PG8_SCHED;
            PG8_LDA(At, 1, 1); PG8_STAGE(PG8_SB(1, 0), b3, voffB); PG8_STAGE(PG8_SB(1, 1), b3 + hstep, voffB); PG8_STAGE(PG8_SA(1, 0), a3, voffA);
            PG8_WAIT_V(8); PG8_WAIT_L(0); PG8_BAR; PG8_MMA(1, 0, At, B0); PG8_MMA(1, 1, At, B1); PG8_BAR; PG8_SCHED;
            } else {
            PG8_LDB(B0, 0, 0); PG8_SCHED; PG8_LDA(At, 0, 0); PG8_STAGE(PG8_SA(1, 1), a1 + hstep, voffA);
            PG8_WAIT_L(8); PG8_BAR; PG8_WAIT_L(0); PG8_MMA(0, 0, At, B0); PG8_BAR; PG8_SCHED;
            PG8_LDB(B1, 0, 1); PG8_STAGE(PG8_SB(0, 0), b2, voffB);
            PG8_BAR; PG8_WAIT_L(0); PG8_MMA(0, 1, At, B1); PG8_BAR;
            PG8_LDA(At, 0, 1); PG8_STAGE(PG8_SA(0, 0), a2, voffA);
            PG8_BAR; PG8_WAIT_L(0); PG8_MMA(1, 0, At, B0); PG8_BAR; PG8_SCHED;
            PG8_STAGE(PG8_SB(0, 1), b2 + hstep, voffB);
            PG8_WAIT_V(6); PG8_BAR; PG8_MMA(1, 1, At, B1); PG8_BAR;
            PG8_LDB(B0, 1, 0); PG8_SCHED; PG8_LDA(At, 1, 0); PG8_STAGE(PG8_SA(0, 1), a2 + hstep, voffA);
            PG8_WAIT_L(8); PG8_BAR; PG8_WAIT_L(0); PG8_MMA(0, 0, At, B0); PG8_BAR; PG8_SCHED;
            PG8_LDB(B1, 1, 1); PG8_STAGE(PG8_SB(1, 0), b3, voffB);
            PG8_BAR; PG8_WAIT_L(0); PG8_MMA(0, 1, At, B1); PG8_BAR;
            PG8_LDA(At, 1, 1); PG8_STAGE(PG8_SA(1, 0), a3, voffA);
            PG8_BAR; PG8_WAIT_L(0); PG8_MMA(1, 0, At, B0); PG8_BAR; PG8_SCHED;
            PG8_STAGE(PG8_SB(1, 1), b3 + hstep, voffB);
            PG8_WAIT_V(6); PG8_BAR; PG8_MMA(1, 1, At, B1); PG8_BAR;
            }
        }
        if constexpr (ALIGN_EPI) { if (wr == 0) PG8_BAR; }
        if constexpr (F8) asm volatile("s_nop 15\n\ts_nop 15" ::: "memory");
        if (!cur.split) { E(acc, cur, wr, wc, fr, fq, 0xffffu); }
        if (!has_next) break;
#pragma unroll
        for (int a = 0; a < 2; ++a)
#pragma unroll
            for (int b = 0; b < 2; ++b)
#pragma unroll
                for (int m = 0; m < 4; ++m)
#pragma unroll
                    for (int n = 0; n < 2; ++n) acc[a][b][m][n] = (f32x4){0.f, 0.f, 0.f, 0.f};
        cur = nxt; cA = nA; cB = nB; ++ui;
        if constexpr (ALIGN_EPI) { if (wr == 1) PG8_BAR; }
    }
    PG8_WAIT_V(0);
    if constexpr (!ALIGN_EPI) { if (wr == 0) PG8_BAR; }
    PG8_BAR;
    if (cur.split) {
        const __amdgpu_buffer_rsrc_t rs = __builtin_amdgcn_make_buffer_rsrc((void*)(S.slab + (size_t)S.c * SLAB_BYTES), (short)0, (int)SLAB_BYTES, 0x00020000);
#pragma unroll
        for (int ai = 0; ai < 2; ++ai)
#pragma unroll
            for (int m = 0; m < 4; ++m)
#pragma unroll
                for (int bj = 0; bj < 2; ++bj) { const f32x4 a0 = acc[ai][bj][m][0], a1 = acc[ai][bj][m][1]; u32x4 w; w.x = cvtpk(a0[0], a0[1]); w.y = cvtpk(a0[2], a0[3]); w.z = cvtpk(a1[0], a1[1]); w.w = cvtpk(a1[2], a1[3]);
                    __builtin_amdgcn_raw_buffer_store_b128(w, rs, tid * 16, (((ai * 4 + m) * 2 + bj) * 512) * 16, 16); }
        asm volatile("s_waitcnt vmcnt(0)" ::: "memory"); PG8_BAR;
        unsigned* cnt = S.cnt + 32 * cur.tile;
        if (tid == 0) __hip_atomic_fetch_add(cnt, 1u, __ATOMIC_RELAXED, __HIP_MEMORY_SCOPE_AGENT);
        const int R = cur.S < 16 ? cur.S : 16;
        if (cur.s < R) {
            if (wid == 0) { unsigned polls = 0;
                while ((unsigned)__builtin_amdgcn_readfirstlane(__hip_atomic_load(cnt, __ATOMIC_RELAXED, __HIP_MEMORY_SCOPE_AGENT)) < (unsigned)cur.S) { __builtin_amdgcn_s_sleep(2); if (++polls > (1u << 22)) break; }
                __builtin_amdgcn_fence(__ATOMIC_ACQUIRE, "agent"); asm volatile("s_waitcnt vmcnt(0)" ::: "memory"); }
            asm volatile("" ::: "memory"); PG8_BAR; asm volatile("" ::: "memory");
            unsigned mask = 0u;
#pragma unroll
            for (int p = 0; p < 16; ++p) if ((p % R) == cur.s) { mask |= 1u << p;
                f32x4 s0 = (f32x4){0.f, 0.f, 0.f, 0.f}, s1 = (f32x4){0.f, 0.f, 0.f, 0.f};
                for (int s2 = 0; s2 < cur.S; s2 += 8) {
                    u32x4 v[8];
#pragma unroll
                    for (int j = 0; j < 8; ++j) { const int sj = (s2 + j < cur.S) ? s2 + j : cur.s;
                        const __amdgpu_buffer_rsrc_t rp = __builtin_amdgcn_make_buffer_rsrc((void*)(S.slab + (size_t)(cur.xw + 8 * sj * cur.rx) * SLAB_BYTES), (short)0, (int)SLAB_BYTES, 0x00020000);
                        v[j] = __builtin_amdgcn_raw_buffer_load_b128(rp, tid * 16, p * 512 * 16, 0); }
#pragma unroll
                    for (int j = 0; j < 8; ++j) if (s2 + j < cur.S) {
                        s0[0] += __uint_as_float(v[j].x << 16); s0[1] += __uint_as_float(v[j].x & 0xffff0000u); s0[2] += __uint_as_float(v[j].y << 16); s0[3] += __uint_as_float(v[j].y & 0xffff0000u);
                        s1[0] += __uint_as_float(v[j].z << 16); s1[1] += __uint_as_float(v[j].z & 0xffff0000u); s1[2] += __uint_as_float(v[j].w << 16); s1[3] += __uint_as_float(v[j].w & 0xffff0000u); } }
                acc[p >> 3][p & 1][(p >> 1) & 3][0] = s0; acc[p >> 3][p & 1][(p >> 1) & 3][1] = s1; }
            E(acc, cur, wr, wc, fr, fq, mask);
        }
    }
#undef PG8_SA
#undef PG8_SB
#undef PG8_STAGE
#undef PG8_LDA
#undef PG8_LDB
#undef PG8_MMA
#undef PG8_WAIT_V
#undef PG8_WAIT_L
#undef PG8_BAR
#undef PG8_SCHED
}
}
#define GAS __attribute__((address_space(1)))
#define LAS __attribute__((address_space(3)))
typedef unsigned short bf16;
typedef unsigned v4u __attribute__((ext_vector_type(4)));
typedef unsigned v2u __attribute__((ext_vector_type(2)));
typedef float f32x4 __attribute__((ext_vector_type(4)));
typedef short bf16x8 __attribute__((ext_vector_type(8)));
typedef short s16x4 __attribute__((ext_vector_type(4)));
typedef GAS unsigned gu32;
#define LDS_WAIT() asm volatile("s_waitcnt lgkmcnt(0)" ::: "memory")
#define VM_WAIT() asm volatile("s_waitcnt vmcnt(0)" ::: "memory")
using pg8::cvtpk;
__device__ __forceinline__ float bf_lo(unsigned w) { return __uint_as_float(w << 16); }
__device__ __forceinline__ float bf_hi(unsigned w) { return __uint_as_float(w & 0xffff0000u); }
__device__ __forceinline__ float wave_sum(float v) {
#pragma unroll
    for (int o = 1; o < 64; o <<= 1) v += __shfl_xor(v, o);
    return v;
}
__device__ __forceinline__ bf16x8 mk8(v4u a) { return __builtin_bit_cast(bf16x8, a); }
#define MFMA16(a, b, c) __builtin_amdgcn_mfma_f32_16x16x32_bf16((a), (b), (c), 0, 0, 0)
#define XB_TMO      128
#define XB_XCNT(j)  (256  + 64 * (j))
#define XB_XSUB(j)  (1280 + 64 * (j))
#define XB_XGEN(j)  (2304 + 64 * (j))
#define XB_TOP      3328
#define XB_TOPGEN   3392
#define XCD_BAR_WORDS 3456
#define XB_SPIN_CAP (1u << 18)

__device__ __forceinline__ unsigned xb_ld(unsigned* p)              { return __hip_atomic_load(p, __ATOMIC_RELAXED, __HIP_MEMORY_SCOPE_AGENT); }
__device__ __forceinline__ unsigned xb_add(unsigned* p, unsigned v) { return __hip_atomic_fetch_add(p, v, __ATOMIC_RELAXED, __HIP_MEMORY_SCOPE_AGENT); }
__device__ __forceinline__ unsigned xb_xcc_id() { return (unsigned)__builtin_amdgcn_s_getreg((3 << 11) | 20) & 0xFu; }
#define XB_SPIN(cond, bar) do { unsigned _sp = 0; while (cond) { __builtin_amdgcn_s_sleep(1); \
    if ((++_sp & 255u) == 0u) { if (xb_ld(&(bar)[XB_TMO])) break; if (_sp > XB_SPIN_CAP) { atomicAdd(&(bar)[XB_TMO], 1u); break; } } } } while (0)

struct XcdBarrier {
    unsigned* bar; unsigned x;
    volatile LAS unsigned* st;
};

__device__ __forceinline__ XcdBarrier xcd_barrier_post(unsigned* bar, volatile LAS unsigned* st) {
    XcdBarrier b; b.bar = bar; b.x = xb_xcc_id(); b.st = st;
    if (threadIdx.x == 0) (void)xb_add(&bar[XB_XCNT(b.x)], 1u);
    return b;
}
__device__ __forceinline__ void xcd_barrier_complete(unsigned* bar, unsigned x, unsigned& nloc, unsigned& nx) {
    const unsigned G = gridDim.x * gridDim.y * gridDim.z;
    unsigned sum, cnt, mine, sp = 0u;
    for (;;) {
        sum = 0u; cnt = 0u; mine = 0u;
#pragma unroll
        for (unsigned j = 0; j < 16; ++j) { const unsigned c = xb_ld(&bar[XB_XCNT(j)]); sum += c; cnt += (c > 0u) ? 1u : 0u; mine = (j == x) ? c : mine; }
        if (sum == G) break;
        __builtin_amdgcn_s_sleep(1);
        if ((++sp & 255u) == 0u) { if (xb_ld(&bar[XB_TMO])) break; if (sp > XB_SPIN_CAP) { atomicAdd(&bar[XB_TMO], 1u); break; } }
    }
    nloc = mine > 0u ? mine : 1u; nx = cnt > 0u ? cnt : 1u;
}

__device__ __forceinline__ void xcd_barrier(const XcdBarrier& b) {
    asm volatile("s_waitcnt vmcnt(0)" ::: "memory");
    __syncthreads();
    if (threadIdx.x == 0) {
        unsigned* bar = b.bar;
        __builtin_amdgcn_s_waitcnt(0);
        unsigned nloc = b.st[0], nx = b.st[1];
        if (nloc == 0u) { xcd_barrier_complete(bar, b.x, nloc, nx); b.st[0] = nloc; b.st[1] = nx; }
        const unsigned old = xb_add(&bar[XB_XSUB(b.x)], 1u);
        const unsigned gen = old / nloc;
        if (old + 1u == (gen + 1u) * nloc) {
            __builtin_amdgcn_fence(__ATOMIC_RELEASE, "agent");
            asm volatile("s_waitcnt vmcnt(0)" ::: "memory");
            const unsigned og = xb_add(&bar[XB_TOP], 1u);
            const unsigned tg = og / nx;
            if (og + 1u == (tg + 1u) * nx) xb_add(&bar[XB_TOPGEN], 1u);
            else XB_SPIN(xb_ld(&bar[XB_TOPGEN]) == tg, bar);
            __builtin_amdgcn_fence(__ATOMIC_ACQUIRE, "agent");
            xb_add(&bar[XB_XGEN(b.x)], 1u);
            asm volatile("s_waitcnt vmcnt(0)" ::: "memory");
        } else {
            XB_SPIN(xb_ld(&bar[XB_XGEN(b.x)]) == gen, bar);
            __builtin_amdgcn_fence(__ATOMIC_ACQUIRE, "agent");
            asm volatile("s_waitcnt vmcnt(0)" ::: "memory");
        }
    }
    __syncthreads();
}

struct Args { const float* in[27]; float* out; unsigned char* ws; int ph_lo, ph_hi; };
struct Frame {
    LAS unsigned char* lds; volatile LAS unsigned* MISC;
    int tid, lane, wave, vcu, G;
    const Args* a;
};
#define A_IN(k) (F.a->in[k])
#define A_WS(T, off) ((T*)(F.a->ws + (off)))
#define A_OUT (F.a->out)
#define A_XF (F.a->out + OUT_Y)
#define A_SSQ(k) ((unsigned long long*)(F.a->ws + CTL_SSQ_BYTE) + (size_t)(k) * M)

template <bool F8>
__device__ __forceinline__ void p0_load(const float* W, int ldn, const float* gain, int k0, int n0, int lane, f32x4 (&va)[8], f32x4 (&vb)[8], float (&ga)[8], float (&gb)[8]) {
    const int nq = lane & 15, kr = lane >> 4; const float gsc = F8 ? 64.f : 1.f;
#pragma unroll
    for (int j = 0; j < 8; ++j) { const int ka = k0 + 8 * j + 2 * kr;
        va[j] = *(const f32x4*)(W + (size_t)ka * ldn + n0 + 4 * nq); vb[j] = *(const f32x4*)(W + (size_t)(ka + 1) * ldn + n0 + 4 * nq);
        ga[j] = gain ? gain[ka] * gsc : gsc; gb[j] = gain ? gain[ka + 1] * gsc : gsc; }
}
template <int MODE, bool F8>
__device__ __forceinline__ void p0_store(int ldk, bf16* WT, LAS unsigned char* scr, int k0, int n0, int lane, const f32x4 (&va)[8], const f32x4 (&vb)[8], const float (&ga)[8], const float (&gb)[8]) {
    const int nq = lane & 15, kr = lane >> 4;
#pragma unroll
    for (int j = 0; j < 8; ++j)
#pragma unroll
        for (int e = 0; e < 4; ++e) *(LAS unsigned*)(scr + (4 * nq + e) * 128 + ((j ^ (nq & 7)) << 4) + 4 * kr) = cvtpk(va[j][e] * ga[j], vb[j][e] * gb[j]);
    LDS_WAIT(); asm volatile("" ::: "memory");
#pragma unroll
    for (int i = 0; i < 8; ++i) {
        const int n = (lane >> 3) + 8 * i, c = lane & 7;
        const v4u o = *(const LAS v4u*)(scr + n * 128 + ((c ^ ((n >> 2) & 7)) << 4));
        const int nn = n0 + n;
        const int r = (MODE == 0) ? nn : (32 * (nn >> 4) + (nn & 15) + (MODE == 2 ? 16 : 0));
        if constexpr (F8) { v2u q; q.x = pg8::pack4_fp8(bf_lo(o.x), bf_hi(o.x), bf_lo(o.y), bf_hi(o.y)); q.y = pg8::pack4_fp8(bf_lo(o.z), bf_hi(o.z), bf_lo(o.w), bf_hi(o.w));
            *(v2u*)((unsigned char*)WT + (size_t)r * ldk + k0 + 8 * c) = q; }
        else *(v4u*)(WT + (size_t)r * ldk + k0 + 8 * c) = o;
    }
    LDS_WAIT(); asm volatile("" ::: "memory");
}
template <int MODE, bool F8 = false>
__device__ __forceinline__ void p0_matrix(Frame& F, const float* W, int K, int ldn, int ncols, const float* gain, bf16* WT, int gw, int NGW) {
    LAS unsigned char* scr = F.lds + F.wave * 18432;
    const int ntn = ncols / 64, nt = (K / 64) * ntn;
    const int ldk = (K == D) ? LDX : (K == FFN ? LDH : K);
    for (int it = 2 * gw; it < nt; it += 2 * NGW) { const int it2 = it + 1;
        f32x4 va[8], vb[8], wa[8], wb[8]; float ga[8], gb[8], ha[8], hb[8];
        p0_load<F8>(W, ldn, gain, (it / ntn) * 64, (it % ntn) * 64, F.lane, va, vb, ga, gb);
        if (it2 < nt) p0_load<F8>(W, ldn, gain, (it2 / ntn) * 64, (it2 % ntn) * 64, F.lane, wa, wb, ha, hb);
        p0_store<MODE, F8>(ldk, WT, scr, (it / ntn) * 64, (it % ntn) * 64, F.lane, va, vb, ga, gb);
        if (it2 < nt) p0_store<MODE, F8>(ldk, WT, scr, (it2 / ntn) * 64, (it2 % ntn) * 64, F.lane, wa, wb, ha, hb); }
}
__device__ __forceinline__ void p0_late_weights(Frame& F, int gw, int NGW) {
    p0_matrix<0>(F, A_IN(18), D, D, D, nullptr, A_WS(bf16, WS_WOUT), gw, NGW);
    p0_matrix<1, true>(F, A_IN(20), D, FFN, FFN, A_IN(19), A_WS(bf16, WS_W2GU), gw, NGW);
    p0_matrix<2, true>(F, A_IN(21), D, FFN, FFN, A_IN(19), A_WS(bf16, WS_W2GU), gw, NGW);
    p0_matrix<0, true>(F, A_IN(22), FFN, D, D, nullptr, A_WS(bf16, WS_W2D), gw, NGW);
}
__device__ __forceinline__ void p0_ple_weights(Frame& F, int gw, int NGW) {
    p0_matrix<0, true>(F, A_IN(24), D, D, D, A_IN(23), A_WS(bf16, WS_WPG), gw, NGW);
}
__device__ __forceinline__ void p0_prologue(Frame& F) {
    const int gw = F.vcu * NWAVES + F.wave, NGW = F.G * NWAVES;
    p0_matrix<1>(F, A_IN(10), D, FFN, FFN, A_IN(9), A_WS(bf16, WS_W1GU), gw, NGW);
    p0_matrix<2>(F, A_IN(11), D, FFN, FFN, A_IN(9), A_WS(bf16, WS_W1GU), gw, NGW);
    p0_matrix<0>(F, A_IN(12), FFN, D, D, nullptr, A_WS(bf16, WS_W1D), gw, NGW);
    p0_matrix<0>(F, A_IN(14), D, NINF, NIN, A_IN(13), A_WS(bf16, WS_WIN), gw, NGW);
    p0_matrix<0>(F, A_IN(25), PLE, D, D, nullptr, A_WS(bf16, WS_WPP), gw, NGW);
    for (int row = gw; row < M; row += NGW) {
        const float* src = row < MP ? A_IN(0) + (size_t)row * D : A_IN(1) + (size_t)(row - MP) * D;
        const f32x4* xr = (const f32x4*)src + F.lane; v2u* o = (v2u*)(A_WS(bf16, WS_XB) + (size_t)row * LDX) + F.lane; float s = 0.f;
#pragma unroll
        for (int j = 0; j < 16; ++j) { const f32x4 v = xr[64 * j]; s += (v[0] * v[0] + v[1] * v[1]) + (v[2] * v[2] + v[3] * v[3]); v2u w; w.x = cvtpk(v[0], v[1]); w.y = cvtpk(v[2], v[3]); o[64 * j] = w; }
        s = wave_sum(s);
        if (F.lane == 0) A_SSQ(0)[row] = pg8::ssq_fix(s);
    }
    const int gt = F.vcu * NWAVES * 64 + F.tid, NGT = F.G * NWAVES * 64;
    for (int i = gt; i < M * (PLE / 4); i += NGT) {
        const f32x4 v = (i < MP * (PLE / 4)) ? ((const f32x4*)A_IN(7))[i] : ((const f32x4*)A_IN(8))[i - MP * (PLE / 4)];
        v2u w; w.x = cvtpk(v[0], v[1]); w.y = cvtpk(v[2], v[3]); ((v2u*)A_WS(bf16, WS_PB))[i] = w;
    }
    for (int i = gt; i < 8 * D; i += NGT) { const int j = i / D, k = i % D; A_WS(float, WS_WIF)[i] = A_IN(13)[k] * A_IN(14)[(size_t)k * NINF + NIN + j]; }
}

__device__ __forceinline__ void gates_rows(Frame& F) {
    const int gw = F.vcu * NWAVES + F.wave, NGW = F.G * NWAVES;
    float acc[5][8];
#pragma unroll
    for (int r = 0; r < 5; ++r)
#pragma unroll
        for (int jj = 0; jj < 8; ++jj) acc[r][jj] = 0.f;
    for (int j = 0; j < 16; ++j) {
        f32x4 wv[8];
#pragma unroll
        for (int jj = 0; jj < 8; ++jj) wv[jj] = *(const f32x4*)(A_WS(float, WS_WIF) + jj * D + 256 * j + 4 * F.lane);
#pragma unroll
        for (int r = 0; r < 5; ++r) { const int row = gw + NGW * r;
            if (row < M) { const v2u xw = *(const v2u*)(A_WS(bf16, WS_XB) + (size_t)row * D + 256 * j + 4 * F.lane); f32x4 x; x[0] = bf_lo(xw.x); x[1] = bf_hi(xw.x); x[2] = bf_lo(xw.y); x[3] = bf_hi(xw.y);
#pragma unroll
                for (int jj = 0; jj < 8; ++jj) acc[r][jj] += (x[0] * wv[jj][0] + x[1] * wv[jj][1]) + (x[2] * wv[jj][2] + x[3] * wv[jj][3]); } }
    }
#pragma unroll
    for (int r = 0; r < 5; ++r) { const int row = gw + NGW * r;
        if (row < M) { const float rs = pg8::rs_of(A_SSQ(1), row);
#pragma unroll
            for (int jj = 0; jj < 8; ++jj) { const float s = wave_sum(acc[r][jj]); if (F.lane == jj) A_WS(float, WS_GATES)[(size_t)row * 8 + jj] = s * rs + A_IN(15)[jj]; } } }
}

__device__ __forceinline__ bf16x8 cvt8(const f32x4 a, const f32x4 b) { v4u w; w.x = cvtpk(a[0], a[1]); w.y = cvtpk(a[2], a[3]); w.z = cvtpk(b[0], b[1]); w.w = cvtpk(b[2], b[3]); return mk8(w); }
__device__ __forceinline__ s16x4 tr16(LAS unsigned char* p) { typedef short v4i16_t __attribute__((ext_vector_type(4))); return __builtin_bit_cast(s16x4, __builtin_amdgcn_ds_read_tr16_b64_v4i16((LAS v4i16_t*)p)); }
constexpr int SB_VLD = 288, SB_VBYTES = 64 * SB_VLD;
__device__ __forceinline__ void sb_unit(Frame& F, int unit, LAS unsigned char* vl) {
    const int lane = F.lane, i16 = lane & 15, g = lane >> 4;
    const int h = unit & 15, qrow0 = (unit >> 4) * 16;
    const bool samp = qrow0 >= MP;
    int pos0, krow_base; const float* ck = nullptr; const float* cv = nullptr;
    if (!samp) { pos0 = qrow0 & (SEQ - 1); krow_base = qrow0 - pos0; }
    else { const int bs = (qrow0 - MP) >> 5; pos0 = PAST + ((qrow0 - MP) & 31); krow_base = MP + bs * DSEQ - PAST;
           ck = A_IN(2) + (size_t)bs * PAST * SBW + h * SBD; cv = A_IN(3) + (size_t)bs * PAST * SBW + h * SBD; }
    const int qpos = pos0 + i16;
    bf16x8 qf[4];
#pragma unroll
    for (int ks = 0; ks < 4; ++ks) qf[ks] = *(const bf16x8*)(A_WS(bf16, WS_QB) + (size_t)(qrow0 + i16) * SBW + h * SBD + 32 * ks + 8 * g);
    f32x4 o[8];
#pragma unroll
    for (int d = 0; d < 8; ++d) o[d] = (f32x4){0.f, 0.f, 0.f, 0.f};
    float P = 1.0f;
    for (int kend = pos0 + 16; kend > 0; kend -= 64) {
        const int kbase = kend - 64;
        f32x4 beta[4], omb[4];
        if (!samp) {
            v4u vv[16]; bf16x8 kf[4][4];
#pragma unroll
            for (int i = 0; i < 16; ++i) { const int key = (lane >> 4) + 4 * i, dc = lane & 15; int pos = kbase + key; pos = pos < 0 ? 0 : pos;
                vv[i] = *(const v4u*)(A_WS(bf16, WS_VB) + (size_t)(krow_base + pos) * SBW + h * SBD + 8 * dc); }
#pragma unroll
            for (int kt = 0; kt < 4; ++kt) { int t0 = kbase + 16 * kt; t0 = t0 < 0 ? 0 : t0;
#pragma unroll
                for (int ks = 0; ks < 4; ++ks) kf[kt][ks] = *(const bf16x8*)(A_WS(bf16, WS_KB) + (size_t)(krow_base + t0 + i16) * SBW + h * SBD + 32 * ks + 8 * g); }
#pragma unroll
            for (int i = 0; i < 16; ++i) { const int key = (lane >> 4) + 4 * i, dc = lane & 15; *(LAS v4u*)(vl + key * SB_VLD + dc * 16) = vv[i]; }
#pragma unroll
            for (int kt = 0; kt < 4; ++kt) { const int t0 = kbase + 16 * kt;
                f32x4 acc = (f32x4){0.f, 0.f, 0.f, 0.f};
#pragma unroll
                for (int ks = 0; ks < 4; ++ks) acc = MFMA16(kf[kt][ks], qf[ks], acc);
#pragma unroll
                for (int r = 0; r < 4; ++r) { const float z = acc[r]; const float e = __expf(-fabsf(z)); const float rr = __builtin_amdgcn_rcpf(1.0f + e), er = e * rr;
                    const bool ok = t0 >= 0 && (t0 + 4 * g + r) < qpos;
                    beta[kt][r] = ok ? (z >= 0.f ? rr : er) : 0.f; omb[kt][r] = ok ? (z >= 0.f ? er : rr) : 1.f; } }
        } else {
#pragma unroll
        for (int i = 0; i < 16; ++i) {
            const int key = (lane >> 4) + 4 * i, dc = lane & 15; int pos = kbase + key; pos = pos < 0 ? 0 : pos;
            v4u val;
            if (samp && (kbase + 4 * i) < PAST) { const float* p = cv + (size_t)pos * SBW + 8 * dc; const f32x4 a = *(const f32x4*)p, b = *(const f32x4*)(p + 4); val = __builtin_bit_cast(v4u, cvt8(a, b)); }
            else val = *(const v4u*)(A_WS(bf16, WS_VB) + (size_t)(krow_base + pos) * SBW + h * SBD + 8 * dc);
            *(LAS v4u*)(vl + key * SB_VLD + dc * 16) = val;
        }
#pragma unroll
        for (int kt = 0; kt < 4; ++kt) {
            const int t0 = kbase + 16 * kt;
            if (t0 < 0) { beta[kt] = (f32x4){0.f, 0.f, 0.f, 0.f}; omb[kt] = (f32x4){1.f, 1.f, 1.f, 1.f}; continue; }
            f32x4 acc = (f32x4){0.f, 0.f, 0.f, 0.f};
            if (samp && t0 < PAST) {
#pragma unroll
                for (int ks = 0; ks < 4; ++ks) { const float* p = ck + (size_t)(t0 + i16) * SBW + 32 * ks + 8 * g; const f32x4 a = *(const f32x4*)p, b = *(const f32x4*)(p + 4);
                    acc = MFMA16(cvt8(a, b), qf[ks], acc); }
            } else {
#pragma unroll
                for (int ks = 0; ks < 4; ++ks) { const bf16x8 kf = *(const bf16x8*)(A_WS(bf16, WS_KB) + (size_t)(krow_base + t0 + i16) * SBW + h * SBD + 32 * ks + 8 * g); acc = MFMA16(kf, qf[ks], acc); }
            }
#pragma unroll
            for (int r = 0; r < 4; ++r) { const float z = acc[r]; const float e = __expf(-fabsf(z)); const float rr = __builtin_amdgcn_rcpf(1.0f + e), er = e * rr;
                const bool ok = (t0 + 4 * g + r) < qpos;
                beta[kt][r] = ok ? (z >= 0.f ? rr : er) : 0.f; omb[kt][r] = ok ? (z >= 0.f ? er : rr) : 1.f; }
        }
        }
        f32x4 a[4]; float Pc = P;
#pragma unroll
        for (int kt = 3; kt >= 0; --kt) {
            const float s2 = omb[kt][3], s1 = s2 * omb[kt][2], s0 = s1 * omb[kt][1], T = s0 * omb[kt][0];
            const float x1 = __shfl_xor(T, 16), x2 = __shfl_xor(T, 32), x3 = __shfl_xor(T, 48);
            const float Sg = (((g ^ 1) > g) ? x1 : 1.f) * (((g ^ 2) > g) ? x2 : 1.f) * (((g ^ 3) > g) ? x3 : 1.f);
            const float base = Sg * Pc;
            a[kt][0] = beta[kt][0] * s0 * base; a[kt][1] = beta[kt][1] * s1 * base; a[kt][2] = beta[kt][2] * s2 * base; a[kt][3] = beta[kt][3] * base;
            Pc *= (T * x1) * (x2 * x3);
        }
        P = Pc;
#pragma unroll
        for (int ks2 = 0; ks2 < 2; ++ks2) {
            const bf16x8 af = cvt8(a[2 * ks2], a[2 * ks2 + 1]);
#pragma unroll
            for (int d = 0; d < 8; ++d) {
                LAS unsigned char* p = vl + (32 * ks2 + 4 * g + (i16 >> 2)) * SB_VLD + (16 * d + 4 * (i16 & 3)) * 2;
                const s16x4 lo = tr16(p), hi = tr16(p + 16 * SB_VLD);
                const bf16x8 vf = __builtin_shufflevector(lo, hi, 0, 1, 2, 3, 4, 5, 6, 7);
                o[d] = MFMA16(vf, af, o[d]);
            }
        }
        if (__all(P < 7.8886090522101181e-31f)) break;
    }
    float ss = 0.f;
#pragma unroll
    for (int d = 0; d < 8; ++d) ss += (o[d][0] * o[d][0] + o[d][1] * o[d][1]) + (o[d][2] * o[d][2] + o[d][3] * o[d][3]);
    ss += __shfl_xor(ss, 16); ss += __shfl_xor(ss, 32);
    const float rinv = rsqrtf(ss * (1.0f / SBD) + EPS);
    bf16* mrow = A_WS(bf16, WS_MIX) + (size_t)(qrow0 + i16) * LDX + h * SBD + 4 * g;
#pragma unroll
    for (int d = 0; d < 8; ++d) { const f32x4 gv = *(const f32x4*)(A_IN(16) + h * SBD + 16 * d + 4 * g);
        v2u w; w.x = cvtpk(o[d][0] * rinv * gv[0], o[d][1] * rinv * gv[1]); w.y = cvtpk(o[d][2] * rinv * gv[2], o[d][3] * rinv * gv[3]); *(v2u*)(mrow + 16 * d) = w; }
}

constexpr int ML_QS = 0, ML_LD = 528, ML_KS = 33792, ML_TLD = 144, ML_VS = 67584, ML_VSS = 76800, ML_PS = 86016, ML_TAB = 95232;
__device__ __forceinline__ float scan_add(float v, int lane) {
#pragma unroll
    for (int o = 1; o < 64; o <<= 1) { const float t = __shfl_up(v, o); v = (lane >= o) ? v + t : v; }
    return v;
}
__device__ __forceinline__ float scan_max(float v, int lane) {
#pragma unroll
    for (int o = 1; o < 64; o <<= 1) { const float t = __shfl_up(v, o); v = (lane >= o) ? fmaxf(v, t) : v; }
    return v;
}
__device__ __forceinline__ void mlstm_scan(Frame& F, int seq, int h, int vblk, bool samp, bool doval, bool doden) {
    LAS unsigned char* L = F.lds; const int tid = F.tid, lane = F.lane, w = F.wave, i16 = lane & 15, g = lane >> 4;
    const int nsteps = samp ? 1 : SEQ / CHUNK, Lvalid = samp ? DSEQ : CHUNK;
    const int row0 = samp ? MP + seq * DSEQ : seq * SEQ, vbase = vblk * 64; const bool vw = w < 4;
    LAS float* tab = (LAS float*)(L + ML_TAB); LAS float* nvec = tab + 192; LAS float* dpart = tab + 448; LAS float* rsp = tab + 960;
    f32x4 C[16]; float m;
    if (samp) { const float* c0 = A_IN(4) + ((size_t)(seq * MLH + h) * MLV + vbase + 16 * (w & 3) + i16) * MLQK + 4 * g;
#pragma unroll
        for (int dt = 0; dt < 16; ++dt) C[dt] = *(const f32x4*)(c0 + 16 * dt);
        m = A_IN(6)[seq * MLH + h]; if (tid < MLQK) nvec[tid] = A_IN(5)[(seq * MLH + h) * MLQK + tid]; }
    else {
#pragma unroll
        for (int dt = 0; dt < 16; ++dt) C[dt] = (f32x4){0.f, 0.f, 0.f, 0.f};
        m = 0.f; if (tid < MLQK) nvec[tid] = 0.f; }
    v4u qreg[4], kreg[4], vreg; f32x4 sc4; float aav, wprev_n;
#define ML_PREFETCH(cc) do { const int rowc_ = row0 + CHUNK * (cc); \
        _Pragma("unroll") for (int i = 0; i < 4; ++i) { const int id = tid + 512 * i, r = id >> 5, c16 = id & 31; \
            if (r < Lvalid) { qreg[i] = *(const v4u*)(A_WS(bf16, WS_MQ) + (size_t)(rowc_ + r) * 1024 + h * MLQK + 8 * c16); kreg[i] = *(const v4u*)(A_WS(bf16, WS_MK) + (size_t)(rowc_ + r) * 1024 + h * MLQK + 8 * c16); } \
            else { qreg[i] = (v4u){0u, 0u, 0u, 0u}; kreg[i] = (v4u){0u, 0u, 0u, 0u}; } } \
        { const int r = tid >> 3, c8 = tid & 7; \
            if (r < Lvalid) vreg = *(const v4u*)(A_WS(bf16, WS_MV) + (size_t)(rowc_ + r) * 2048 + h * MLV + vbase + 8 * c8); else vreg = (v4u){0u, 0u, 0u, 0u}; } \
        sc4 = *(const f32x4*)(GS + ((size_t)(cc) * 64 + lane) * 4); aav = GS[16384 + (cc) * 64 + lane]; wprev_n = GS[20480 + (cc)]; } while (0)
    float* GS = A_WS(float, WS_MLS) + (size_t)blockIdx.x * 21504;
    {   LAS float* ptab = (LAS float*)(L + ML_QS);
        float pb[8], pa[8], pA[8];
#pragma unroll
        for (int k = 0; k < 8; ++k) { const int cc = w + 8 * k; pb[k] = 0.f; pa[k] = -INFINITY; pA[k] = -INFINITY;
            if (cc < nsteps) { float gi, gf; const int rowc_ = row0 + CHUNK * cc;
                if (lane < Lvalid) { gi = A_WS(float, WS_GATES)[(size_t)(rowc_ + lane) * 8 + h]; gf = A_WS(float, WS_GATES)[(size_t)(rowc_ + lane) * 8 + 4 + h]; } else { gi = -INFINITY; gf = 1e30f; }
                const float lf = fminf(gf, 0.f) - log1pf(expf(-fabsf(gf)));
                pb[k] = scan_add(lf, lane); pa[k] = gi - pb[k]; pA[k] = scan_max(pa[k], lane);
                if (lane == Lvalid - 1) { ptab[2 * cc] = pb[k]; ptab[2 * cc + 1] = pA[k]; } } }
        __syncthreads();
        const float Bc = lane < nsteps ? ptab[2 * lane] : 0.f, Ac = lane < nsteps ? ptab[2 * lane + 1] : -INFINITY;
        float mcur = m, mstart = m, mend = m;
        for (int cc = 0; cc < nsteps; ++cc) { const float mn = __shfl(Bc, cc) + fmaxf(mcur, __shfl(Ac, cc)); if (lane == cc) { mstart = mcur; mend = mn; } mcur = mn; }
        m = mcur;
#pragma unroll
        for (int k = 0; k < 8; ++k) { const int cc = w + 8 * k;
            if (cc < nsteps) { const float mc = __shfl(mstart, cc), mnew = __shfl(mend, cc), blast = __shfl(pb[k], Lvalid - 1);
                const float mrow = pb[k] + fmaxf(mc, pA[k]);
                f32x4 o; o[0] = expf(blast + pa[k] - mnew); o[1] = expf(pb[k] + mc - mrow); o[2] = expf(-mrow); o[3] = pb[k] - mrow;
                *(f32x4*)(GS + ((size_t)cc * 64 + lane) * 4) = o; GS[16384 + cc * 64 + lane] = pa[k];
                if (lane == 0) GS[20480 + cc] = expf(blast + mc - mnew); } }
        asm volatile("s_waitcnt vmcnt(0)" ::: "memory");
        __syncthreads(); }
    ML_PREFETCH(0);
    for (int c = 0; c < nsteps; ++c) {
        const int rowc = row0 + CHUNK * c;
        const float wtok = sc4[0], winter = sc4[1], emr = sc4[2], uu = sc4[3], aa = aav, wprev = wprev_n;
#pragma unroll
        for (int i = 0; i < 4; ++i) { const int id = tid + 512 * i, r = id >> 5, c16 = id & 31; *(LAS v4u*)(L + ML_QS + r * ML_LD + c16 * 16) = qreg[i]; *(LAS v4u*)(L + ML_KS + r * ML_LD + c16 * 16) = kreg[i]; }
        { const int r = tid >> 3, c8 = tid & 7; const float wt = __shfl(wtok, r);
            *(LAS v4u*)(L + ML_VS + r * ML_TLD + c8 * 16) = vreg;
            v4u sv; sv.x = cvtpk(bf_lo(vreg.x) * wt, bf_hi(vreg.x) * wt); sv.y = cvtpk(bf_lo(vreg.y) * wt, bf_hi(vreg.y) * wt); sv.z = cvtpk(bf_lo(vreg.z) * wt, bf_hi(vreg.z) * wt); sv.w = cvtpk(bf_lo(vreg.w) * wt, bf_hi(vreg.w) * wt);
            *(LAS v4u*)(L + ML_VSS + r * ML_TLD + c8 * 16) = sv; }
        if (w == 0) { tab[lane] = wtok; tab[64 + lane] = winter; tab[128 + lane] = emr; tab[1088 + lane] = uu; tab[1152 + lane] = aa; }
        if (c + 1 < nsteps) ML_PREFETCH(c + 1);
        __syncthreads();
#define SB0() __builtin_amdgcn_sched_barrier(0)
        {   if (!vw) { const int tt = w - 4; float rsum = 0.f; const float ut = tab[1088 + 16 * tt + i16];
            bf16x8 fq[8];
#pragma unroll
            for (int ks = 0; ks < 8; ++ks) fq[ks] = *(const LAS bf16x8*)(L + ML_QS + (16 * tt + i16) * ML_LD + (32 * ks + 8 * g) * 2);
#pragma unroll
            for (int st = 0; st < 4; ++st) { f32x4 acc = (f32x4){0.f, 0.f, 0.f, 0.f};
                if (st <= tt) { bf16x8 fk[8];
#pragma unroll
                    for (int ks = 0; ks < 8; ++ks) fk[ks] = *(const LAS bf16x8*)(L + ML_KS + (16 * st + i16) * ML_LD + (32 * ks + 8 * g) * 2);
                    SB0();
#pragma unroll
                    for (int ks = 0; ks < 8; ++ks) acc = MFMA16(fk[ks], fq[ks], acc);
                    SB0(); }
                f32x4 pv; const f32x4 as4 = *(const LAS f32x4*)(tab + 1152 + 16 * st + 4 * g);
#pragma unroll
                for (int r = 0; r < 4; ++r) { const float as = as4[r]; const bool ok = (st < tt) || (st == tt && (4 * g + r) <= i16); pv[r] = ok ? acc[r] * __expf(ut + as) : 0.f; }
                rsum += (pv[0] + pv[1]) + (pv[2] + pv[3]);
                v2u pw; pw.x = cvtpk(pv[0], pv[1]); pw.y = cvtpk(pv[2], pv[3]); *(LAS v2u*)(L + ML_PS + (16 * tt + i16) * ML_TLD + (16 * st + 4 * g) * 2) = pw; }
            rsum += __shfl_xor(rsum, 16); rsum += __shfl_xor(rsum, 32);
            if (g == 0) { rsp[(16 * tt + i16) * 2] = rsum; rsp[(16 * tt + i16) * 2 + 1] = 0.f; } }
            if (doden) { float dp = 0.f; v4u qq[4]; f32x4 nn0[4], nn1[4];
#pragma unroll
            for (int c4 = 0; c4 < 4; ++c4) { qq[c4] = *(const LAS v4u*)(L + ML_QS + lane * ML_LD + (32 * w + 8 * c4) * 2); nn0[c4] = *(const LAS f32x4*)(nvec + 32 * w + 8 * c4); nn1[c4] = *(const LAS f32x4*)(nvec + 32 * w + 8 * c4 + 4); }
#pragma unroll
            for (int c4 = 0; c4 < 4; ++c4) dp += (bf_lo(qq[c4].x) * nn0[c4][0] + bf_hi(qq[c4].x) * nn0[c4][1]) + (bf_lo(qq[c4].y) * nn0[c4][2] + bf_hi(qq[c4].y) * nn0[c4][3]) + (bf_lo(qq[c4].z) * nn1[c4][0] + bf_hi(qq[c4].z) * nn1[c4][1]) + (bf_lo(qq[c4].w) * nn1[c4][2] + bf_hi(qq[c4].w) * nn1[c4][3]);
            dpart[lane * 8 + w] = dp; } }
        f32x4 Y[4];
#pragma unroll
        for (int t2 = 0; t2 < 4; ++t2) Y[t2] = (f32x4){0.f, 0.f, 0.f, 0.f};
        if (vw && doval) {
#define ML_LDQ(dst, ks_) do { _Pragma("unroll") for (int t2 = 0; t2 < 4; ++t2) { const LAS unsigned char* qp = L + ML_QS + (16 * t2 + i16) * ML_LD + (32 * (ks_) + 4 * g) * 2; const v2u b0 = *(const LAS v2u*)qp, b1 = *(const LAS v2u*)(qp + 32); \
            dst[t2].x = b0.x; dst[t2].y = b0.y; dst[t2].z = b1.x; dst[t2].w = b1.y; } } while (0)
        v4u qa[4], qb[4];
        ML_LDQ(qa, 0);
#pragma unroll
        for (int ks = 0; ks < 8; ks += 2) {
            ML_LDQ(qb, ks + 1); SB0();
            { const bf16x8 af = cvt8(C[2 * ks], C[2 * ks + 1]);
#pragma unroll
              for (int t2 = 0; t2 < 4; ++t2) Y[t2] = MFMA16(af, mk8(qa[t2]), Y[t2]); }
            SB0();
            if (ks + 2 < 8) ML_LDQ(qa, ks + 2);
            SB0();
            { const bf16x8 af = cvt8(C[2 * ks + 2], C[2 * ks + 3]);
#pragma unroll
              for (int t2 = 0; t2 < 4; ++t2) Y[t2] = MFMA16(af, mk8(qb[t2]), Y[t2]); }
            SB0(); }
#undef ML_LDQ
#pragma unroll
        for (int t2 = 0; t2 < 4; ++t2) Y[t2] = Y[t2] * tab[64 + 16 * t2 + i16];
#pragma unroll
        for (int dt = 0; dt < 16; ++dt) C[dt] = C[dt] * wprev;
#pragma unroll
        for (int ks = 0; ks < 2; ++ks) { LAS unsigned char* tp = L + (32 * ks + 8 * g + (i16 >> 2)) * ML_TLD + (16 * w + 4 * (i16 & 3)) * 2;
            LAS unsigned char* kp = L + ML_KS + (32 * ks + 8 * g + (i16 >> 2)) * ML_LD + (4 * (i16 & 3)) * 2;
            const s16x4 blo = tr16(tp + ML_VSS), bhi = tr16(tp + ML_VSS + 4 * ML_TLD);
            const bf16x8 B = __builtin_shufflevector(blo, bhi, 0, 1, 2, 3, 4, 5, 6, 7);
#pragma unroll
            for (int dh = 0; dh < 16; dh += 8) { s16x4 alo[8], ahi[8];
#pragma unroll
                for (int dt = 0; dt < 8; ++dt) { alo[dt] = tr16(kp + 32 * (dh + dt)); ahi[dt] = tr16(kp + 32 * (dh + dt) + 4 * ML_LD); }
                SB0();
#pragma unroll
                for (int dt = 0; dt < 8; ++dt) { const bf16x8 A = __builtin_shufflevector(alo[dt], ahi[dt], 0, 1, 2, 3, 4, 5, 6, 7); C[dh + dt] = MFMA16(A, B, C[dh + dt]); }
                SB0(); } }
        }
        __syncthreads();
        if (vw && doval) {
            s16x4 alo[2], ahi[2]; bf16x8 pb[2][4];
#pragma unroll
            for (int ks = 0; ks < 2; ++ks) { LAS unsigned char* tp = L + ML_VS + (32 * ks + 8 * g + (i16 >> 2)) * ML_TLD + (16 * w + 4 * (i16 & 3)) * 2; alo[ks] = tr16(tp); ahi[ks] = tr16(tp + 4 * ML_TLD);
#pragma unroll
                for (int t2 = 0; t2 < 4; ++t2) pb[ks][t2] = *(const LAS bf16x8*)(L + ML_PS + (16 * t2 + i16) * ML_TLD + (32 * ks + 8 * g) * 2); }
            SB0();
#pragma unroll
            for (int ks = 0; ks < 2; ++ks) { const bf16x8 A = __builtin_shufflevector(alo[ks], ahi[ks], 0, 1, 2, 3, 4, 5, 6, 7);
#pragma unroll
                for (int t2 = 0; t2 < 4; ++t2) Y[t2] = MFMA16(A, pb[ks][t2], Y[t2]); }
            SB0();
#pragma unroll
        for (int t2 = 0; t2 < 4; ++t2) { const int t = 16 * t2 + i16; if (t < Lvalid) *(f32x4*)(A_WS(float, WS_NUM) + (size_t)(rowc + t) * 2048 + h * MLV + vbase + 16 * w + 4 * g) = Y[t2]; }
        }
        if (doden) { if (tid < CHUNK) { float dq = 0.f;
#pragma unroll
            for (int j = 0; j < 8; ++j) dq += dpart[tid * 8 + j];
            const float den = tab[64 + tid] * dq + rsp[2 * tid] + rsp[2 * tid + 1]; const float dd = fmaxf(fabsf(den), tab[128 + tid]);
            if (tid < Lvalid) A_WS(float, WS_DEN)[(size_t)(rowc + tid) * MLH + h] = dd; }
#pragma unroll
        for (int dd2 = 0; dd2 < 2; ++dd2) { const int dt = 2 * w + dd2; float an = 0.f;
#pragma unroll
            for (int sb = 0; sb < 4; ++sb) { const s16x4 kv = tr16(L + ML_KS + (16 * sb + 4 * g + (i16 >> 2)) * ML_LD + (16 * dt + 4 * (i16 & 3)) * 2); const f32x4 w4 = *(const LAS f32x4*)(tab + 16 * sb + 4 * g);
                an += (__uint_as_float((unsigned)(unsigned short)kv[0] << 16) * w4[0] + __uint_as_float((unsigned)(unsigned short)kv[1] << 16) * w4[1]) + (__uint_as_float((unsigned)(unsigned short)kv[2] << 16) * w4[2] + __uint_as_float((unsigned)(unsigned short)kv[3] << 16) * w4[3]); }
            an += __shfl_xor(an, 16); an += __shfl_xor(an, 32);
            if (g == 0) nvec[16 * dt + i16] = wprev * nvec[16 * dt + i16] + an; } }
        __syncthreads();
    }
#undef ML_PREFETCH
    float* oc = A_OUT + (samp ? OUT_MLC_S : OUT_MLC_P) + ((size_t)(seq * MLH + h) * MLV + vbase + 16 * (w & 3) + i16) * MLQK + 4 * g;
    if (vw && doval) {
#pragma unroll
    for (int dt = 0; dt < 16; ++dt) *(f32x4*)(oc + 16 * dt) = C[dt]; }
    if (doden) { if (tid < MLQK) A_OUT[(samp ? OUT_MLN_S : OUT_MLN_P) + (seq * MLH + h) * MLQK + tid] = nvec[tid]; if (tid == 0) A_OUT[(samp ? OUT_MLM_S : OUT_MLM_P) + seq * MLH + h] = m; }
    __syncthreads();
}

__device__ __forceinline__ void ml_post(Frame& F) {
    const int gw = F.vcu * NWAVES + F.wave, NGW = F.G * NWAVES;
    for (int it0 = gw; it0 < M * MLH; it0 += 4 * NGW) {
        f32x4 a[4], b[4]; float dn[4]; v4u ow[4];
#pragma unroll
        for (int k = 0; k < 4; ++k) { int it = it0 + k * NGW; it = it < M * MLH ? it : it0; const int row = it >> 2, h = it & 3;
            const float* np = A_WS(float, WS_NUM) + (size_t)row * 2048 + h * MLV + 8 * F.lane; a[k] = *(const f32x4*)np; b[k] = *(const f32x4*)(np + 4);
            dn[k] = A_WS(float, WS_DEN)[(size_t)row * MLH + h]; ow[k] = *(const v4u*)(A_WS(bf16, WS_MO) + (size_t)row * 2048 + h * MLV + 8 * F.lane); }
#pragma unroll
        for (int k = 0; k < 4; ++k) { const int it = it0 + k * NGW; if (it >= M * MLH) continue; const int row = it >> 2, h = it & 3;
            const float dinv = 1.0f / dn[k];
            float hv[8] = {a[k][0] * dinv, a[k][1] * dinv, a[k][2] * dinv, a[k][3] * dinv, b[k][0] * dinv, b[k][1] * dinv, b[k][2] * dinv, b[k][3] * dinv};
            float ss = 0.f;
#pragma unroll
            for (int e = 0; e < 8; ++e) ss += hv[e] * hv[e];
            ss = wave_sum(ss);
            const float rinv = rsqrtf(ss * (1.0f / MLV) + EPS);
            const float* gp = A_IN(17) + h * MLV + 8 * F.lane; const f32x4 g0 = *(const f32x4*)gp, g1 = *(const f32x4*)(gp + 4);
            const float ov[8] = {bf_lo(ow[k].x), bf_hi(ow[k].x), bf_lo(ow[k].y), bf_hi(ow[k].y), bf_lo(ow[k].z), bf_hi(ow[k].z), bf_lo(ow[k].w), bf_hi(ow[k].w)};
            const float gv[8] = {g0[0], g0[1], g0[2], g0[3], g1[0], g1[1], g1[2], g1[3]};
            float y[8];
#pragma unroll
            for (int e = 0; e < 8; ++e) y[e] = hv[e] * rinv * gv[e] / (1.0f + __expf(-ov[e]));
            v4u wv; wv.x = cvtpk(y[0], y[1]); wv.y = cvtpk(y[2], y[3]); wv.z = cvtpk(y[4], y[5]); wv.w = cvtpk(y[6], y[7]);
            *(v4u*)(A_WS(bf16, WS_MIX) + (size_t)row * LDX + 2048 + h * MLV + 8 * F.lane) = wv; } }
}
__device__ __forceinline__ void final_norm(Frame& F) {
    const int gw = F.vcu * NWAVES + F.wave, NGW = F.G * NWAVES;
    for (int row = gw; row < M; row += NGW) { const float rs = pg8::rs_of(A_SSQ(4), row); const v4u* xr = (const v4u*)(A_WS(bf16, WS_XB) + (size_t)row * D) + F.lane; f32x4* yr = (f32x4*)(A_XF + (size_t)row * D) + 2 * F.lane; const f32x4* gr = (const f32x4*)A_IN(26) + 2 * F.lane;
#pragma unroll
        for (int j = 0; j < 8; ++j) { const v4u v = xr[64 * j]; const f32x4 g0 = gr[128 * j], g1 = gr[128 * j + 1];
            __builtin_nontemporal_store((f32x4){bf_lo(v.x), bf_hi(v.x), bf_lo(v.y), bf_hi(v.y)} * rs * g0, yr + 128 * j); __builtin_nontemporal_store((f32x4){bf_lo(v.z), bf_hi(v.z), bf_lo(v.w), bf_hi(v.w)} * rs * g1, yr + 128 * j + 1); } }
}

__global__ void __launch_bounds__(NWAVES * 64, 2) hsm_fwd(Args args) {
    extern __shared__ __attribute__((aligned(16))) unsigned char lds[];
    Frame F;
    F.lds = (LAS unsigned char*)lds; F.MISC = (volatile LAS unsigned*)(F.lds + MISC_OFF);
    F.tid = threadIdx.x; F.lane = F.tid & 63; F.wave = __builtin_amdgcn_readfirstlane(F.tid >> 6);
    F.G = gridDim.x; { const int bx = blockIdx.x; F.vcu = (F.G % 8 == 0) ? (bx % 8) * (F.G / 8) + bx / 8 : bx; }
    unsigned char* ws = args.ws; F.a = &args;
    for (int u = F.tid; u < 64; u += NWAVES * 64) ((LAS unsigned*)(F.lds + MISC_OFF))[u] = 0u;
    __syncthreads();
    XcdBarrier bar; bar.bar = (unsigned*)(ws + CTL_BAR_BYTE); bar.x = 0; bar.st = nullptr;
    if (MK_N_LAUNCHES == 1) bar = xcd_barrier_post((unsigned*)(ws + CTL_BAR_BYTE), F.MISC + 8);
    const int lo = args.ph_lo, hi = args.ph_hi;
#ifndef PH_MASK
#define PH_MASK 0x7ff
#endif
#define IN(k) (((PH_MASK >> (k)) & 1) && lo <= (k) && (k) < hi)
#define SEAM(k) do { if (IN(k) && IN((k) + 1)) xcd_barrier(bar); } while (0)
    const int bx = (int)blockIdx.x;

    if (IN(0)) { p0_prologue(F); } SEAM(0);
    if (IN(1)) {
        { pg8::Gemm g{A_WS(bf16, WS_XB), A_WS(bf16, WS_W1GU), M, NGU, D, LDX}; pg8::SplitOrder S; S.init(M, NGU, D, F.G, bx, F.a->ws + WS_SLAB, (unsigned*)(F.a->ws + CTL_CNT_BYTE) + 0 * 512 * 32); pg8::EpiGateUp<false, false> E{F.a->ws, WS_HB, 0}; pg8::gemm_phase<pg8::EpiGateUp<false, false>, pg8::SplitOrder, true, true>(F.lds, g, S, E); }
    } SEAM(1);
    if (IN(2)) { pg8::Gemm g{A_WS(bf16, WS_HB), A_WS(bf16, WS_W1D), M, D, FFN, LDH}; pg8::SplitOrder S; S.init(M, D, FFN, F.G, bx, F.a->ws + WS_SLAB, (unsigned*)(F.a->ws + CTL_CNT_BYTE) + 1 * 512 * 32); pg8::EpiResid<false, true> E{nullptr, nullptr, F.a->ws, 0.5f, 1};
        pg8::gemm_phase<pg8::EpiResid<false, true>, pg8::SplitOrder, true, true>(F.lds, g, S, E); } SEAM(2);
    if (IN(3)) { gates_rows(F);
        pg8::Gemm g{A_WS(bf16, WS_XB), A_WS(bf16, WS_WIN), M, NIN, D, LDX}; pg8::SplitOrder S; S.init(M, NIN, D, F.G, bx, F.a->ws + WS_SLAB, (unsigned*)(F.a->ws + CTL_CNT_BYTE) + 2 * 512 * 32);
        pg8::EpiWin E{F.a->ws, A_OUT};
        pg8::gemm_phase<pg8::EpiWin, pg8::SplitOrder, true, true>(F.lds, g, S, E); } SEAM(3);
    if (IN(4)) {
        if (bx < 72) { const bool dn = bx >= 64; const int sh = dn ? bx - 64 : (bx & 7);
            mlstm_scan(F, sh >> 2, sh & 3, dn ? 0 : (bx >> 3), false, !dn, dn); }
        else { const int j = bx - 72, nb = F.G - 72;
            { pg8::Gemm g{A_WS(bf16, WS_PB), A_WS(bf16, WS_WPP), M, D, PLE, PLE}; pg8::SplitOrder S; S.init(M, D, PLE, nb, j, F.a->ws + WS_SLAB, (unsigned*)(F.a->ws + CTL_CNT_BYTE) + 3 * 512 * 32); pg8::EpiPlain E{A_WS(bf16, WS_PP), D}; pg8::gemm_phase<pg8::EpiPlain, pg8::SplitOrder, true, true>(F.lds, g, S, E); }
            __syncthreads();
            for (int su = j; su < DBATCH * MLH * 8; su += nb) mlstm_scan(F, su >> 5, (su >> 3) & 3, su & 7, true, true, (su & 7) == 0);
            const int nw = nb * NWAVES;
            __syncthreads();
            if (F.wave < 4) { for (int u = j * NWAVES + F.wave; u < (M / 16) * SBH; u += nw) sb_unit(F, u, F.lds + F.wave * SB_VBYTES); p0_late_weights(F, j * NWAVES + F.wave, nw); p0_ple_weights(F, j * NWAVES + F.wave, nw); }
            else { p0_late_weights(F, j * NWAVES + F.wave, nw); p0_ple_weights(F, j * NWAVES + F.wave, nw); for (int u = j * NWAVES + F.wave; u < (M / 16) * SBH; u += nw) sb_unit(F, u, F.lds + F.wave * SB_VBYTES); } }
    } SEAM(4);
    if (IN(5)) { ml_post(F); } SEAM(5);
    if (IN(6)) { pg8::Gemm g{A_WS(bf16, WS_MIX), A_WS(bf16, WS_WOUT), M, D, D, LDX}; pg8::SplitOrder S; S.init(M, D, D, F.G, bx, F.a->ws + WS_SLAB, (unsigned*)(F.a->ws + CTL_CNT_BYTE) + 4 * 512 * 32); pg8::EpiResid<true, true> E{nullptr, nullptr, F.a->ws, 1.0f, 2};
        pg8::gemm_phase<pg8::EpiResid<true, true>, pg8::SplitOrder, true, true>(F.lds, g, S, E); } SEAM(6);
    if (IN(7)) { pg8::Gemm g{A_WS(bf16, WS_XB8), A_WS(bf16, WS_W2GU), M, NGU, D / 2, D / 2}; pg8::SplitOrder S; S.init(M, NGU, D / 2, F.G, bx, F.a->ws + WS_SLAB, (unsigned*)(F.a->ws + CTL_CNT_BYTE) + 5 * 512 * 32); pg8::EpiGateUp<true, true> E{F.a->ws, WS_HB, 2};
        pg8::gemm_phase<pg8::EpiGateUp<true, true>, pg8::SplitOrder, true, true, true>(F.lds, g, S, E); } SEAM(7);
    if (IN(8)) { pg8::Gemm g{A_WS(bf16, WS_HB), A_WS(bf16, WS_W2D), M, D, FFN / 2, FFN / 2}; pg8::SplitOrder S; S.init(M, D, FFN / 2, F.G, bx, F.a->ws + WS_SLAB, (unsigned*)(F.a->ws + CTL_CNT_BYTE) + 6 * 512 * 32); pg8::EpiResid<true, true> E{nullptr, nullptr, F.a->ws, 0.5f / 64.f, 3};
        pg8::gemm_phase<pg8::EpiResid<true, true>, pg8::SplitOrder, true, true, true>(F.lds, g, S, E); } SEAM(8);
    if (IN(9)) { pg8::Gemm g{A_WS(bf16, WS_XB8), A_WS(bf16, WS_WPG), M, D, D / 2, D / 2}; pg8::SplitOrder S; S.init(M, D, D / 2, F.G, bx, F.a->ws + WS_SLAB, (unsigned*)(F.a->ws + CTL_CNT_BYTE) + 7 * 512 * 32); pg8::EpiPle E{F.a->ws, 1.0f / 64.f};
        pg8::gemm_phase<pg8::EpiPle, pg8::SplitOrder, true, true, true>(F.lds, g, S, E); } SEAM(9);
    if (IN(10)) { final_norm(F); }
#undef IN
#undef SEAM
}

extern "C" void kernel_launch(void* const* d_in, const int* in_sizes, int n_in, void* d_out, int out_size, void* d_ws, size_t ws_size, hipStream_t stream) {
    static int grid = 0;
    if (grid == 0) {
        if (n_in != 27 || out_size != (int)OUT_END || ws_size < WS_END) { fprintf(stderr, "kernel_launch: unexpected shapes (n_in %d, out %d, ws %zu; need ws >= %zu)\n", n_in, out_size, ws_size, (size_t)WS_END); grid = -1; return; }
        int dev = 0, cus = 0, per_cu = 0;
        if (hipGetDevice(&dev) != hipSuccess || hipDeviceGetAttribute(&cus, hipDeviceAttributeMultiprocessorCount, dev) != hipSuccess) { grid = -1; return; }
        if (hipFuncSetAttribute((const void*)hsm_fwd, hipFuncAttributeMaxDynamicSharedMemorySize, LDS_BYTES) != hipSuccess) { fprintf(stderr, "kernel_launch: hipFuncSetAttribute failed\n"); grid = -1; return; }
        if (hipOccupancyMaxActiveBlocksPerMultiprocessor(&per_cu, (const void*)hsm_fwd, NWAVES * 64, LDS_BYTES) != hipSuccess || per_cu < 1) fprintf(stderr, "kernel_launch: occupancy query says %d\n", per_cu);
        (void)hipGetLastError();
        grid = cus;
    }
    if (grid < 0) return;
    if (hipMemsetAsync((char*)d_ws + WS_CTL, 0, CTL_ZERO_BYTES, stream) != hipSuccess) return;
    Args a{};
    for (int i = 0; i < 27; ++i) a.in[i] = (const float*)d_in[i];
    a.out = (float*)d_out; a.ws = (unsigned char*)d_ws;
#if MK_N_LAUNCHES == 1
    a.ph_lo = 0; a.ph_hi = N_PHASES;
    hipLaunchKernelGGL(hsm_fwd, dim3(grid), dim3(NWAVES * 64), LDS_BYTES, stream, a);
#else
    for (int p = 0; p < N_PHASES; ++p) { a.ph_lo = p; a.ph_hi = p + 1; hipLaunchKernelGGL(hsm_fwd, dim3(grid), dim3(NWAVES * 64), LDS_BYTES, stream, a); }
#endif
}
```
